# Optimizing an MI355X kernel written in HIP

```python
import jax, jax.numpy as jnp
from jax import lax
import numpy as np

D_MODEL = 1024
BATCH = 4
SEQ = 8192
DEPTH = 4

N_MIXERS = 2
N_LAYERS_A = (DEPTH + N_MIXERS - 1) // N_MIXERS
N_LAYERS_B = DEPTH // N_MIXERS
LRU_WIDTH = D_MODEL
LRU_HEADS = 4
LRU_HEAD_DIM = LRU_WIDTH // LRU_HEADS
CONV_WIDTH = 4
LRU_C = 8.0
MIN_RAD = 0.9
MAX_RAD = 0.999
POOL_WINDOWS = (2, 4, 8, 16)
POOL_GROUPS = len(POOL_WINDOWS)
POOL_GROUP_DIM = D_MODEL // POOL_GROUPS
D_FF = 4 * D_MODEL
N_MOD = 6
EPS = 1e-6

kernel_name = "hybrid_rglru_multiscale_pool_adaln"


def rms_norm(x, g):
    xf = x.astype(jnp.float32)
    y = xf * lax.rsqrt(jnp.mean(xf * xf, axis=-1, keepdims=True) + EPS)
    return (y * g.astype(jnp.float32)).astype(x.dtype)


def modulate(h, shift, scale):
    return h * (1.0 + scale[:, None, :]) + shift[:, None, :]


def causal_depthwise_conv(x, w, b):
    s = x.shape[1]
    xp = jnp.pad(x, ((0, 0), (CONV_WIDTH - 1, 0), (0, 0)))
    y = xp[:, 0:s] * w[0]
    for k in range(1, CONV_WIDTH):
        y = y + xp[:, k:k + s] * w[k]
    return y + b


def _lru_combine(left, right):
    a1, b1 = left
    a2, b2 = right
    return a1 * a2, a2 * b1 + b2


def block_diag_linear(x, w, b):
    bsz, s, _ = x.shape
    xh = x.reshape(bsz, s, LRU_HEADS, LRU_HEAD_DIM)
    y = jnp.einsum("bshi,hij->bshj", xh, w) + b
    return y.reshape(bsz, s, LRU_WIDTH)


def rg_lru(x, w_a, b_a, w_x, b_x, lam):
    gate_r = jax.nn.sigmoid(block_diag_linear(x, w_a, b_a)).astype(jnp.float32)
    gate_i = jax.nn.sigmoid(block_diag_linear(x, w_x, b_x)).astype(jnp.float32)
    log_a = LRU_C * gate_r * jax.nn.log_sigmoid(lam.astype(jnp.float32))
    a = jnp.exp(log_a)
    mult = jnp.sqrt(-jnp.expm1(2.0 * log_a))
    u = mult * (gate_i * x.astype(jnp.float32))
    _, h = lax.associative_scan(_lru_combine, (a, u), axis=1)
    return h.astype(x.dtype)


def recurrent_mixer(h, w_y, b_y, w_in, b_in, conv_w, conv_b, w_a, b_a, w_x, b_x, lam, w_out, b_out):
    gate_branch = jax.nn.gelu(jnp.einsum("bsd,dw->bsw", h, w_y) + b_y)
    xr = jnp.einsum("bsd,dw->bsw", h, w_in) + b_in
    xr = causal_depthwise_conv(xr, conv_w, conv_b)
    xr = rg_lru(xr, w_a, b_a, w_x, b_x, lam)
    return jnp.einsum("bsw,wd->bsd", xr * gate_branch, w_out) + b_out


def pool_mixer(h, w_pool, pool_scale):
    bsz, s, _ = h.shape
    hf = h.astype(jnp.float32)
    counts = jnp.arange(1, s + 1, dtype=jnp.float32)
    outs = []
    for g, win in enumerate(POOL_WINDOWS):
        xg = hf[..., g * POOL_GROUP_DIM:(g + 1) * POOL_GROUP_DIM]
        cs = jnp.cumsum(xg, axis=1)
        cs_lag = jnp.pad(cs, ((0, 0), (win, 0), (0, 0)))[:, :s]
        mean = (cs - cs_lag) / jnp.minimum(counts, float(win))[None, :, None]
        outs.append(mean - xg)
    pooled = jnp.stack(outs, axis=2).astype(h.dtype)
    mixed = jnp.einsum("bsgi,gij->bsgj", pooled, w_pool).reshape(bsz, s, D_MODEL)
    return mixed * pool_scale


def sq_relu_mlp(h, w1, w2):
    u = jax.nn.relu(jnp.einsum("bsd,df->bsf", h, w1))
    return jnp.einsum("bsf,fd->bsd", u * u, w2)


def setup_inputs(seed: int = 0) -> dict:
    key = jax.random.key(seed)
    ks = jax.random.split(key, 26)
    f32 = jnp.float32
    nrm = lambda k, shape, s: (jax.random.normal(k, shape, f32) * s)
    d, w, hd, na, nb = D_MODEL, LRU_WIDTH, LRU_HEAD_DIM, N_LAYERS_A, N_LAYERS_B
    rad = jnp.sqrt(jax.random.uniform(ks[15], (na, w), f32, MIN_RAD ** 2, MAX_RAD ** 2))
    return {
        "x": nrm(ks[0], (BATCH, SEQ, d), 1.0),
        "c": nrm(ks[1], (BATCH, d), 1.0),
        "w_mod": nrm(ks[2], (DEPTH, d, N_MOD * d), 0.5 * d ** -0.5),
        "b_mod": nrm(ks[3], (DEPTH, N_MOD * d), 0.02),
        "norm_mix_g": 1.0 + nrm(ks[4], (DEPTH, d), 0.05),
        "norm_ffn_g": 1.0 + nrm(ks[5], (DEPTH, d), 0.05),
        "lru_w_y": nrm(ks[6], (na, d, w), d ** -0.5),
        "lru_b_y": nrm(ks[7], (na, w), 0.02),
        "lru_w_in": nrm(ks[8], (na, d, w), d ** -0.5),
        "lru_b_in": nrm(ks[9], (na, w), 0.02),
        "lru_conv_w": nrm(ks[10], (na, CONV_WIDTH, w), CONV_WIDTH ** -0.5),
        "lru_conv_b": nrm(ks[11], (na, w), 0.02),
        "lru_w_a": nrm(ks[12], (na, LRU_HEADS, hd, hd), hd ** -0.5),
        "lru_b_a": nrm(ks[13], (na, LRU_HEADS, hd), 0.02),
        "lru_w_x": nrm(ks[14], (na, LRU_HEADS, hd, hd), hd ** -0.5),
        "lru_b_x": nrm(ks[16], (na, LRU_HEADS, hd), 0.02),
        "lru_lambda": jnp.log(rad) - jnp.log1p(-rad),
        "lru_w_out": nrm(ks[17], (na, w, d), w ** -0.5),
        "lru_b_out": nrm(ks[18], (na, d), 0.02),
        "pool_w": nrm(ks[19], (nb, POOL_GROUPS, POOL_GROUP_DIM, POOL_GROUP_DIM), POOL_GROUP_DIM ** -0.5),
        "pool_scale": 1.0 + nrm(ks[20], (nb, d), 0.1),
        "ffn_w1": nrm(ks[21], (DEPTH, d, D_FF), d ** -0.5),
        "ffn_w2": nrm(ks[22], (DEPTH, D_FF, d), D_FF ** -0.5),
        "final_norm_g": 1.0 + nrm(ks[23], (d,), 0.05),
    }


def reference(x, c, w_mod, b_mod, norm_mix_g, norm_ffn_g, lru_w_y, lru_b_y, lru_w_in, lru_b_in,
              lru_conv_w, lru_conv_b, lru_w_a, lru_b_a, lru_w_x, lru_b_x, lru_lambda, lru_w_out,
              lru_b_out, pool_w, pool_scale, ffn_w1, ffn_w2, final_norm_g):
    cond = jax.nn.silu(c)
    for i in range(DEPTH):
        mod = jnp.einsum("bd,de->be", cond, w_mod[i]) + b_mod[i]
        sh_m, sc_m, gt_m, sh_f, sc_f, gt_f = jnp.split(mod, N_MOD, axis=-1)
        h = modulate(rms_norm(x, norm_mix_g[i]), sh_m, sc_m)
        j = i // N_MIXERS
        if i % N_MIXERS == 0:
            y = recurrent_mixer(h, lru_w_y[j], lru_b_y[j], lru_w_in[j], lru_b_in[j],
                                lru_conv_w[j], lru_conv_b[j], lru_w_a[j], lru_b_a[j],
                                lru_w_x[j], lru_b_x[j], lru_lambda[j], lru_w_out[j], lru_b_out[j])
        else:
            y = pool_mixer(h, pool_w[j], pool_scale[j])
        x = x + gt_m[:, None, :] * y
        h = modulate(rms_norm(x, norm_ffn_g[i]), sh_f, sc_f)
        x = x + gt_f[:, None, :] * sq_relu_mlp(h, ffn_w1[i], ffn_w2[i])
    return rms_norm(x, final_norm_g)
```

```cpp
#include <hip/hip_runtime.h>
#include <hip/hip_cooperative_groups.h>
#include <cstdio>
#include <cstdint>
namespace cg = cooperative_groups;

namespace pg8 {
#define PG8_LAS __attribute__((address_space(3)))
typedef unsigned short bf16_t;
typedef short bf16x8 __attribute__((ext_vector_type(8)));
typedef float f32x4 __attribute__((ext_vector_type(4)));
typedef float f32x2 __attribute__((ext_vector_type(2)));
typedef unsigned u32x4 __attribute__((ext_vector_type(4)));
typedef unsigned u32x2 __attribute__((ext_vector_type(2)));
constexpr int BM = 256, BK = 64, HALF = 128, HTB = HALF * BK * 2, STAGE_BYTES = 8 * HTB, NXCD = 8, WGM = 8;

__host__ __device__ __forceinline__ int lds_byte(int r, int c) { const int st = (r >> 4) * 2 + (c >> 5), rr = r & 15, cc = c & 31, ob = rr * 64 + cc * 2; return st * 1024 + (ob ^ (((ob >> 9) & 1) << 5)); }
__host__ __device__ __forceinline__ void stage_rc(int b, int& R, int& C) { const int st = b / 1024, sb = b % 1024, swz = sb ^ (((sb >> 9) & 1) << 5); R = (st >> 1) * 16 + swz / 64; C = (st & 1) * 32 + (swz % 64) / 2; }
__host__ __device__ __forceinline__ int perm32(int rho) { const int n = rho >> 4, i = rho & 15; return 8 * (i >> 2) + 4 * n + (i & 3); }

struct Unit { int pm, pn; };
struct Gemm { const bf16_t* A; const bf16_t* Bt; int M, N, K, lda, gshift; };

struct StaticOrder {
    int nM, nN, nwg, G, c, flip;
    __host__ __device__ void init(int M, int N, int G_, int c_, int flip_ = 0) { nM = M / BM; nN = N / BM; nwg = nM * nN; G = G_; c = c_; flip = flip_; }
    __host__ __device__ bool next(int i, Unit& u) const {
        const long L = (long)i * G + c; if (L >= nwg) return false;
        int wgid = (int)L; { const int q = nwg / NXCD, r = nwg % NXCD, xcd = wgid % NXCD, off = wgid / NXCD; wgid = (xcd < r ? xcd * (q + 1) : r * (q + 1) + (xcd - r) * q) + off; }
        const int nig = WGM * nN, gid = wgid / nig, fm = gid * WGM, gsz = (nM - fm) < WGM ? (nM - fm) : WGM;
        u.pm = (fm + ((wgid % nig) % gsz)) ^ flip; u.pn = (wgid % nig) / gsz; return true;
    }
};

__device__ __forceinline__ unsigned cvt_pk_bf16(float lo, float hi) { unsigned r; asm volatile("v_cvt_pk_bf16_f32 %0, %1, %2" : "=v"(r) : "v"(lo), "v"(hi)); return r; }
__device__ __forceinline__ __amdgpu_buffer_rsrc_t wt_rsrc(const void* p) { return __builtin_amdgcn_make_buffer_rsrc((void*)p, (short)0, 0x7ffff000, 0x00020000); }
__device__ __forceinline__ void st16_wt(__amdgpu_buffer_rsrc_t rs, unsigned byte_off, u32x4 v) { __builtin_amdgcn_raw_buffer_store_b128(v, rs, (int)byte_off, 0,   16); }
__device__ __forceinline__ void st8_wt(__amdgpu_buffer_rsrc_t rs, unsigned byte_off, u32x2 v) { __builtin_amdgcn_raw_buffer_store_b64(v, rs, (int)byte_off, 0, 16); }
__device__ __forceinline__ void st4_wt(__amdgpu_buffer_rsrc_t rs, unsigned byte_off, unsigned v) { __builtin_amdgcn_raw_buffer_store_b32(v, rs, (int)byte_off, 0, 16); }
__device__ __forceinline__ float bf_lo(unsigned w) { return __uint_as_float(w << 16); }
__device__ __forceinline__ float bf_hi(unsigned w) { return __uint_as_float(w & 0xffff0000u); }
__device__ __forceinline__ float fast_sigmoid(float z) { return __builtin_amdgcn_rcpf(1.0f + __builtin_amdgcn_exp2f(-1.4426950408889634f * z)); }
__device__ __forceinline__ float gelu_tanh(float v) { const float a = 1.5957691216057308f * (v + 0.044715f * v * v * v); return v * fast_sigmoid(a); }


struct EpiG1 {
    static constexpr bool PERM = true;
    bf16_t* gate; bf16_t* xr; const float* b_y; const float* b_in;
    __device__ __forceinline__ void operator()(const f32x4 (&acc)[2][2][4][2], const Unit& u, int wr, int wc, int fr, int fq) const {
        const int row0 = u.pm * BM + wr * 64 + fr; int colt = u.pn * BM; const bool isg = colt < 1024;
        bf16_t* base = isg ? gate : xr; const __amdgpu_buffer_rsrc_t rs = wt_rsrc(base); const float* bias = isg ? b_y : b_in; if (!isg) colt -= 1024;
        const int col0 = colt + wc * 32 + 8 * fq;
        f32x4 bv[2][2];
#pragma unroll
        for (int bj = 0; bj < 2; ++bj)
#pragma unroll
            for (int n = 0; n < 2; ++n) bv[bj][n] = *(const f32x4*)(bias + col0 + bj * HALF + 4 * n);
#pragma unroll
        for (int ai = 0; ai < 2; ++ai)
#pragma unroll
            for (int m = 0; m < 4; ++m) { const unsigned rowb = (unsigned)((row0 + ai * HALF + m * 16) * 1024 + col0) * 2u;
#pragma unroll
                for (int bj = 0; bj < 2; ++bj) { f32x4 v0 = acc[ai][bj][m][0] + bv[bj][0], v1 = acc[ai][bj][m][1] + bv[bj][1];
                    if (isg) { v0 = (f32x4){gelu_tanh(v0[0]), gelu_tanh(v0[1]), gelu_tanh(v0[2]), gelu_tanh(v0[3])}; v1 = (f32x4){gelu_tanh(v1[0]), gelu_tanh(v1[1]), gelu_tanh(v1[2]), gelu_tanh(v1[3])}; }
                    u32x4 w; w.x = cvt_pk_bf16(v0[0], v0[1]); w.y = cvt_pk_bf16(v0[2], v0[3]); w.z = cvt_pk_bf16(v1[0], v1[1]); w.w = cvt_pk_bf16(v1[2], v1[3]);
                    st16_wt(rs, rowb + bj * HALF * 2, w); } }
    }
};
struct EpiFF1 {
    static constexpr bool PERM = true;
    bf16_t* O;
    __device__ __forceinline__ void operator()(const f32x4 (&acc)[2][2][4][2], const Unit& u, int wr, int wc, int fr, int fq) const {
        const int row0 = u.pm * BM + wr * 64 + fr; const int col0 = u.pn * BM + wc * 32 + 8 * fq;
        const __amdgpu_buffer_rsrc_t rs = wt_rsrc(O);
#pragma unroll
        for (int ai = 0; ai < 2; ++ai)
#pragma unroll
            for (int m = 0; m < 4; ++m) { const unsigned rowb = (unsigned)((row0 + ai * HALF + m * 16) * 4096 + col0) * 2u;
#pragma unroll
                for (int bj = 0; bj < 2; ++bj) { f32x4 v0 = acc[ai][bj][m][0], v1 = acc[ai][bj][m][1];
#pragma unroll
                    for (int j = 0; j < 4; ++j) { float a = fmaxf(v0[j], 0.f); v0[j] = a * a; float b = fmaxf(v1[j], 0.f); v1[j] = b * b; }
                    u32x4 w; w.x = cvt_pk_bf16(v0[0], v0[1]); w.y = cvt_pk_bf16(v0[2], v0[3]); w.z = cvt_pk_bf16(v1[0], v1[1]); w.w = cvt_pk_bf16(v1[2], v1[3]);
                    st16_wt(rs, rowb + bj * HALF * 2, w); } }
    }
};
struct EpiGates {
    static constexpr bool PERM = true;
    const bf16_t* xc; bf16_t* loga; bf16_t* uu; const float* b_a; const float* b_x; const float* lcp;
    __device__ __forceinline__ void operator()(f32x4 (&acc)[2][2][4][2], const Unit& u, int wr, int wc, int fr, int fq) const {
        const int head = u.pn >> 1, half = u.pn & 1;
        const int ch0 = head * 256 + half * 128 + wc * 32 + 8 * fq;
        const __amdgpu_buffer_rsrc_t rsl = wt_rsrc(loga), rsu = wt_rsrc(uu);
#pragma unroll
        for (int n = 0; n < 2; ++n) {
            const f32x4 ba = *(const f32x4*)(b_a + ch0 + 4 * n), lc = *(const f32x4*)(lcp + ch0 + 4 * n);
#pragma unroll
            for (int ai = 0; ai < 2; ++ai)
#pragma unroll
                for (int m = 0; m < 4; ++m)
#pragma unroll
                    for (int j = 0; j < 4; ++j) acc[ai][0][m][n][j] = lc[j] * fast_sigmoid(acc[ai][0][m][n][j] + ba[j]);
        }
#pragma unroll
        for (int n = 0; n < 2; ++n) {
            const f32x4 bx = *(const f32x4*)(b_x + ch0 + 4 * n);
#pragma unroll
            for (int ai = 0; ai < 2; ++ai)
#pragma unroll
                for (int m = 0; m < 4; ++m)
#pragma unroll
                    for (int j = 0; j < 4; ++j) { const float x2 = 2.0f * acc[ai][0][m][n][j];
                        const float big = 1.0f - __builtin_amdgcn_exp2f(1.4426950408889634f * x2), small = -x2 * (1.0f + x2 * (0.5f + x2 * 0.16666667f));
                        const float m2 = x2 > -0.01f ? small : big;
                        acc[ai][1][m][n][j] = __builtin_amdgcn_sqrtf(fmaxf(m2, 0.f)) * fast_sigmoid(acc[ai][1][m][n][j] + bx[j]); }
        }
        u32x4 xvv[2][4];
#pragma unroll
        for (int ai = 0; ai < 2; ++ai)
#pragma unroll
            for (int m = 0; m < 4; ++m) xvv[ai][m] = *(const u32x4*)(xc + (size_t)(u.pm * BM + ai * HALF + wr * 64 + m * 16 + fr) * 1024 + ch0);
#pragma unroll
        for (int ai = 0; ai < 2; ++ai)
#pragma unroll
            for (int m = 0; m < 4; ++m) { const size_t off = (size_t)(u.pm * BM + ai * HALF + wr * 64 + m * 16 + fr) * 1024 + ch0;
                const u32x4 xv = xvv[ai][m];
                const f32x4 l0 = acc[ai][0][m][0], l1 = acc[ai][0][m][1], g0 = acc[ai][1][m][0], g1 = acc[ai][1][m][1];
                u32x4 wl, wu;
                wl.x = cvt_pk_bf16(l0[0], l0[1]); wl.y = cvt_pk_bf16(l0[2], l0[3]); wl.z = cvt_pk_bf16(l1[0], l1[1]); wl.w = cvt_pk_bf16(l1[2], l1[3]);
                wu.x = cvt_pk_bf16(g0[0] * bf_lo(xv.x), g0[1] * bf_hi(xv.x)); wu.y = cvt_pk_bf16(g0[2] * bf_lo(xv.y), g0[3] * bf_hi(xv.y));
                wu.z = cvt_pk_bf16(g1[0] * bf_lo(xv.z), g1[1] * bf_hi(xv.z)); wu.w = cvt_pk_bf16(g1[2] * bf_lo(xv.w), g1[3] * bf_hi(xv.w));
                st16_wt(rsl, (unsigned)off * 2u, wl); st16_wt(rsu, (unsigned)off * 2u, wu);
                if (m & 1) asm volatile("" ::: "memory"); }
    }
};
struct EpiXUpd {
    static constexpr bool PERM = true;
    const bf16_t* base; bf16_t* out; const float* gt;   const float* bias; const float* ps;
    __device__ __forceinline__ void operator()(const f32x4 (&acc)[2][2][4][2], const Unit& u, int wr, int wc, int fr, int fq) const {
        const int b = u.pm >> 5; const float* gtp = gt + b * 6144;
        const int col0 = u.pn * BM + wc * 32 + 8 * fq;
        const __amdgpu_buffer_rsrc_t rso = wt_rsrc(out);
        f32x4 mul[2][2], add[2][2];
#pragma unroll
        for (int bj = 0; bj < 2; ++bj)
#pragma unroll
            for (int n = 0; n < 2; ++n) { const int c = col0 + bj * HALF + 4 * n; const f32x4 g4 = *(const f32x4*)(gtp + c);
                mul[bj][n] = ps ? g4 * *(const f32x4*)(ps + c) : g4; add[bj][n] = bias ? g4 * *(const f32x4*)(bias + c) : (f32x4){0.f, 0.f, 0.f, 0.f}; }
#pragma unroll
        for (int ai = 0; ai < 2; ++ai) {
            u32x4 bwv[4][2];
#pragma unroll
            for (int m = 0; m < 4; ++m)
#pragma unroll
                for (int bj = 0; bj < 2; ++bj) bwv[m][bj] = *(const u32x4*)(base + (size_t)(u.pm * BM + ai * HALF + wr * 64 + m * 16 + fr) * 1024 + col0 + bj * HALF);
            asm volatile("" ::: "memory");
#pragma unroll
            for (int m = 0; m < 4; ++m) { const size_t off = (size_t)(u.pm * BM + ai * HALF + wr * 64 + m * 16 + fr) * 1024 + col0;
#pragma unroll
                for (int bj = 0; bj < 2; ++bj) { const u32x4 bw = bwv[m][bj];
                    const f32x4 v0 = (f32x4){bf_lo(bw.x), bf_hi(bw.x), bf_lo(bw.y), bf_hi(bw.y)} + acc[ai][bj][m][0] * mul[bj][0] + add[bj][0];
                    const f32x4 v1 = (f32x4){bf_lo(bw.z), bf_hi(bw.z), bf_lo(bw.w), bf_hi(bw.w)} + acc[ai][bj][m][1] * mul[bj][1] + add[bj][1];
                    st16_wt(rso, (unsigned)(off + bj * HALF) * 2u, (u32x4){cvt_pk_bf16(v0[0], v0[1]), cvt_pk_bf16(v0[2], v0[3]), cvt_pk_bf16(v1[0], v1[1]), cvt_pk_bf16(v1[2], v1[3])}); } }
            asm volatile("" ::: "memory");
        }
    }
};

template <class Epi, class Sched>
__device__ __forceinline__ void gemm_phase(PG8_LAS unsigned char* lds, const Gemm g, const Sched& S, const Epi& E) {
    int tid = threadIdx.x; asm volatile("" : "+v"(tid));
    const int wid = __builtin_amdgcn_readfirstlane(tid >> 6), lane = tid & 63, wr = wid >> 2, wc = wid & 3, fr = lane & 15, fq = lane >> 4;
    const int K = g.K, nt = K / BK, lda = g.lda;
    unsigned voffA[2], voffB[2];
#pragma unroll
    for (int i = 0; i < 2; ++i) { int R, C; stage_rc(tid * 16 + i * 8192, R, C); const int Rb = Epi::PERM ? ((R & ~31) + perm32(R & 31)) : R;
        voffA[i] = (unsigned)(R * lda + C) * 2u; voffB[i] = (unsigned)(Rb * K + C) * 2u; }
    const unsigned kstep = (unsigned)(BK * 2);
    const unsigned hstepA = (unsigned)HALF * lda * 2u, hstepB = (unsigned)HALF * K * 2u;
    const unsigned tstepA = 2u * hstepA, tstepB = 2u * hstepB;
    const __amdgpu_buffer_rsrc_t rsA = __builtin_amdgcn_make_buffer_rsrc((void*)g.A, (short)0, 0x7ffff000, 0x00020000);
    const __amdgpu_buffer_rsrc_t rsB = __builtin_amdgcn_make_buffer_rsrc((void*)g.Bt, (short)0, 0x7ffff000, 0x00020000);
    const unsigned ldsw = (unsigned)wid * 1024u;
    const int aoff = lds_byte(wr * 64 + fr, fq * 8), boff = lds_byte(wc * 32 + fr, fq * 8);
#define PG8_SA(b, h) (((b) * 2 + (h)) * HTB)
#define PG8_SB(b, h) ((4 + (b) * 2 + (h)) * HTB)
#define PG8_STAGE(bufoff, rs, soff, voff) do { _Pragma("unroll") for (int _i = 0; _i < 2; ++_i) \
        __builtin_amdgcn_raw_ptr_buffer_load_lds(rs, (PG8_LAS unsigned*)(lds + (bufoff) + ldsw + _i * 8192), 16, (int)(voff)[_i], (int)(soff), 0, 0); } while (0)
#define PG8_LDA(dst, b, h) do { _Pragma("unroll") for (int m = 0; m < 4; ++m) _Pragma("unroll") for (int k = 0; k < 2; ++k) dst[m][k] = *(const PG8_LAS bf16x8*)(lds + PG8_SA(b, h) + aoff + m * 2048 + k * 1024); } while (0)
#define PG8_LDB(dst, b, h) do { _Pragma("unroll") for (int n = 0; n < 2; ++n) _Pragma("unroll") for (int k = 0; k < 2; ++k) dst[n][k] = *(const PG8_LAS bf16x8*)(lds + PG8_SB(b, h) + boff + n * 2048 + k * 1024); } while (0)
#define PG8_MMA(ai, bj, At, Bt) do { __builtin_amdgcn_s_setprio(1); _Pragma("unroll") for (int m = 0; m < 4; ++m) _Pragma("unroll") for (int n = 0; n < 2; ++n) _Pragma("unroll") for (int k = 0; k < 2; ++k) \
        acc[ai][bj][m][n] = __builtin_amdgcn_mfma_f32_16x16x32_bf16(Bt[n][k], At[m][k], acc[ai][bj][m][n], 0, 0, 0); __builtin_amdgcn_s_setprio(0); } while (0)
#define PG8_WAIT_V(n) asm volatile("s_waitcnt vmcnt(" #n ")" ::: "memory")
#define PG8_WAIT_L(n) asm volatile("s_waitcnt lgkmcnt(" #n ")" ::: "memory")
#define PG8_BAR __builtin_amdgcn_s_barrier()
#define PG8_SCHED __builtin_amdgcn_sched_barrier(0)
#define PG8_APTR(u) ((unsigned)(u).pm * tstepA + (g.gshift >= 0 ? (unsigned)(((u).pn >> g.gshift) * K) * 2u : 0u))
    Unit cur, nxt; int ui = 0;
    if (!S.next(0, cur)) return;
    f32x4 acc[2][2][4][2];
#pragma unroll
    for (int a = 0; a < 2; ++a)
#pragma unroll
        for (int b = 0; b < 2; ++b)
#pragma unroll
            for (int m = 0; m < 4; ++m)
#pragma unroll
                for (int n = 0; n < 2; ++n) acc[a][b][m][n] = (f32x4){0.f, 0.f, 0.f, 0.f};
    bf16x8 At[4][2], B0[2][2], B1[2][2];
    unsigned cA = PG8_APTR(cur), cB = (unsigned)cur.pn * tstepB;
    PG8_STAGE(PG8_SB(0, 0), rsB, cB, voffB); PG8_STAGE(PG8_SB(0, 1), rsB, cB + hstepB, voffB); PG8_STAGE(PG8_SA(0, 0), rsA, cA, voffA); PG8_STAGE(PG8_SA(0, 1), rsA, cA + hstepA, voffA);
    if (wr == 1) PG8_BAR;
    PG8_WAIT_V(2); PG8_BAR;
    PG8_STAGE(PG8_SB(1, 0), rsB, cB + kstep, voffB); PG8_STAGE(PG8_SA(1, 0), rsA, cA + kstep, voffA); PG8_STAGE(PG8_SB(1, 1), rsB, cB + hstepB + kstep, voffB);
    PG8_WAIT_V(6); PG8_BAR;
    for (;;) {
        const bool has_next = S.next(ui + 1, nxt);
        const unsigned nA = has_next ? PG8_APTR(nxt) : cA, nB = has_next ? (unsigned)nxt.pn * tstepB : cB;
        for (int t = 0; t < nt; t += 2) {
            const bool last = (t == nt - 2);
            const unsigned a1 = cA + (unsigned)(t + 1) * kstep;
            const unsigned a2 = last ? nA : cA + (unsigned)(t + 2) * kstep, b2 = last ? nB : cB + (unsigned)(t + 2) * kstep;
            const unsigned a3 = a2 + kstep, b3 = b2 + kstep;
            PG8_LDB(B0, 0, 0); PG8_LDB(B1, 0, 1); PG8_SCHED; PG8_LDA(At, 0, 0); PG8_STAGE(PG8_SA(1, 1), rsA, a1 + hstepA, voffA);
            PG8_WAIT_V(8); PG8_WAIT_L(0); PG8_BAR; PG8_MMA(0, 0, At, B0); PG8_MMA(0, 1, At, B1); PG8_BAR; PG8_SCHED;
            PG8_LDA(At, 0, 1); PG8_STAGE(PG8_SB(0, 0), rsB, b2, voffB); PG8_STAGE(PG8_SB(0, 1), rsB, b2 + hstepB, voffB); PG8_STAGE(PG8_SA(0, 0), rsA, a2, voffA);
            PG8_WAIT_V(8); PG8_WAIT_L(0); PG8_BAR; PG8_MMA(1, 0, At, B0); PG8_MMA(1, 1, At, B1); PG8_BAR; PG8_SCHED;
            PG8_LDB(B0, 1, 0); PG8_LDB(B1, 1, 1); PG8_SCHED; PG8_LDA(At, 1, 0); PG8_STAGE(PG8_SA(0, 1), rsA, a2 + hstepA, voffA);
            PG8_WAIT_V(8); PG8_WAIT_L(0); PG8_BAR; PG8_MMA(0, 0, At, B0); PG8_MMA(0, 1, At, B1); PG8_BAR; PG8_SCHED;
            PG8_LDA(At, 1, 1); PG8_STAGE(PG8_SB(1, 0), rsB, b3, voffB); PG8_STAGE(PG8_SB(1, 1), rsB, b3 + hstepB, voffB); PG8_STAGE(PG8_SA(1, 0), rsA, a3, voffA);
            PG8_WAIT_V(8); PG8_WAIT_L(0); PG8_BAR; PG8_MMA(1, 0, At, B0); PG8_MMA(1, 1, At, B1); PG8_BAR; PG8_SCHED;
        }
        if (wr == 0) PG8_BAR;
        E(acc, cur, wr, wc, fr, fq);
        if (!has_next) break;
#pragma unroll
        for (int a = 0; a < 2; ++a)
#pragma unroll
            for (int b = 0; b < 2; ++b)
#pragma unroll
                for (int m = 0; m < 4; ++m)
#pragma unroll
                    for (int n = 0; n < 2; ++n) acc[a][b][m][n] = (f32x4){0.f, 0.f, 0.f, 0.f};
        cur = nxt; cA = nA; cB = nB; ++ui;
        if (wr == 1) PG8_BAR;
    }
    PG8_WAIT_V(0);
    PG8_BAR;
#undef PG8_SA
#undef PG8_SB
#undef PG8_STAGE
#undef PG8_LDA
#undef PG8_LDB
#undef PG8_MMA
#undef PG8_WAIT_V
#undef PG8_WAIT_L
#undef PG8_BAR
#undef PG8_SCHED
#undef PG8_APTR
}
}

using pg8::wt_rsrc; using pg8::st16_wt; using pg8::st8_wt; using pg8::st4_wt; using pg8::bf16_t; using pg8::f32x4; using pg8::f32x2; using pg8::u32x4; using pg8::u32x2; using pg8::cvt_pk_bf16; using pg8::bf_lo; using pg8::bf_hi;
constexpr int NWAVES = 8, NTHR = 512;
constexpr int NB = 4, SEQ = 8192, D = 1024, FF = 4096, T = NB * SEQ, DEPTH = 4;
constexpr float EPS = 1e-6f;
constexpr int LC = 64, NCHUNK = T / LC;
constexpr size_t MiB = 1u << 20;
constexpr size_t WS_CTL = 0, CTL_ZERO_BYTES = 64 * 1024;
constexpr size_t WS_MOD = 1 * MiB;
constexpr size_t WS_PAR = WS_MOD + 512 * 1024;
constexpr int P_NMG = 0, P_NFG = 4096, P_BY = 8192, P_BIN = 10240, P_CW = 12288, P_CB = 20480, P_BA = 22528, P_BX = 24576, P_LC = 26624, P_BOUT = 28672, P_PS = 30720, P_FG = 32768, P_END = 33792;
constexpr size_t WS_AGA = 2 * MiB, WS_AGH = 4 * MiB, WS_CAR = 6 * MiB;
constexpr size_t WS_WYI = 8 * MiB;
constexpr size_t WS_WG = 16 * MiB;
constexpr size_t WS_WOUT = 18 * MiB;
constexpr size_t WS_WPOOL = 22 * MiB;
constexpr size_t WS_W1 = 24 * MiB;
constexpr size_t WS_W2 = 56 * MiB;
constexpr size_t WS_H = 88 * MiB;
constexpr size_t WS_U = 152 * MiB;
constexpr size_t WS_GATE = WS_U, WS_XR = WS_U + 64 * MiB, WS_XC = WS_U + 128 * MiB, WS_LOGA = WS_U + 192 * MiB;
constexpr size_t WS_XB = 408 * MiB;
constexpr size_t WS_END = 472 * MiB;
constexpr int LDS_BYTES = 135168;
constexpr int MISC_OFF = 131072;

#define LAS __attribute__((address_space(3)))
#define LDS_WAIT() asm volatile("s_waitcnt lgkmcnt(0)" ::: "memory")

#define XB_TMO      128
#define XB_XCNT(j)  (256  + 64 * (j))
#define XB_XSUB(j)  (1280 + 64 * (j))
#define XB_XGEN(j)  (2304 + 64 * (j))
#define XB_TOP      3328
#define XB_TOPGEN   3392
#define XCD_BAR_WORDS 3456
#define XB_SPIN_CAP (1u << 18)
__device__ __forceinline__ unsigned xb_ld(unsigned* p)              { return __hip_atomic_load(p, __ATOMIC_RELAXED, __HIP_MEMORY_SCOPE_AGENT); }
__device__ __forceinline__ unsigned xb_add(unsigned* p, unsigned v) { return __hip_atomic_fetch_add(p, v, __ATOMIC_RELAXED, __HIP_MEMORY_SCOPE_AGENT); }
__device__ __forceinline__ unsigned xb_xcc_id() { return (unsigned)__builtin_amdgcn_s_getreg((3 << 11) | 20) & 0xFu; }
#define XB_SPIN(cond, bar) do { unsigned _sp = 0; while (cond) { __builtin_amdgcn_s_sleep(1); \
    if ((++_sp & 255u) == 0u) { if (xb_ld(&(bar)[XB_TMO])) break; if (_sp > XB_SPIN_CAP) { atomicAdd(&(bar)[XB_TMO], 1u); break; } } } } while (0)
struct XcdBarrier { unsigned* bar; unsigned x; volatile LAS unsigned* st; };
__device__ __forceinline__ XcdBarrier xcd_barrier_post(unsigned* bar, volatile LAS unsigned* st) {
    XcdBarrier b; b.bar = bar; b.x = xb_xcc_id(); b.st = st;
    if (threadIdx.x == 0) { (void)xb_add(&bar[XB_XCNT(b.x)], 1u); st[2] = b.x; }
    return b;
}
__device__ __forceinline__ void xcd_barrier_complete(unsigned* bar, unsigned x, unsigned& nloc, unsigned& nx) {
    const unsigned G = gridDim.x * gridDim.y * gridDim.z;
    unsigned sum, cnt, mine, sp = 0u;
    for (;;) {
        sum = 0u; cnt = 0u; mine = 0u;
#pragma unroll
        for (unsigned j = 0; j < 16; ++j) { const unsigned c = xb_ld(&bar[XB_XCNT(j)]); sum += c; cnt += (c > 0u) ? 1u : 0u; mine = (j == x) ? c : mine; }
        if (sum == G) break;
        __builtin_amdgcn_s_sleep(1);
        if ((++sp & 255u) == 0u) { if (xb_ld(&bar[XB_TMO])) break; if (sp > XB_SPIN_CAP) { atomicAdd(&bar[XB_TMO], 1u); break; } }
    }
    nloc = mine > 0u ? mine : 1u; nx = cnt > 0u ? cnt : 1u;
}
__device__ __forceinline__ void xcd_barrier(unsigned* bar, volatile LAS unsigned* st) {
    asm volatile("s_waitcnt vmcnt(0)" ::: "memory");
    __syncthreads();
    if (threadIdx.x == 0) {
        struct { unsigned x; } b; b.x = (unsigned)__builtin_amdgcn_readfirstlane((int)st[2]);
        __builtin_amdgcn_s_waitcnt(0);
        unsigned nloc = st[0], nx = st[1];
        if (nloc == 0u) { xcd_barrier_complete(bar, b.x, nloc, nx); st[0] = nloc; st[1] = nx; }
        const unsigned old = xb_add(&bar[XB_XSUB(b.x)], 1u);
        const unsigned gen = old / nloc;
        if (old + 1u == (gen + 1u) * nloc) {
            __builtin_amdgcn_fence(__ATOMIC_RELEASE, "agent");
            asm volatile("s_waitcnt vmcnt(0)" ::: "memory");
            const unsigned og = xb_add(&bar[XB_TOP], 1u);
            const unsigned tg = og / nx;
            if (og + 1u == (tg + 1u) * nx) xb_add(&bar[XB_TOPGEN], 1u);
            else XB_SPIN(xb_ld(&bar[XB_TOPGEN]) == tg, bar);
            __builtin_amdgcn_fence(__ATOMIC_ACQUIRE, "agent");
            xb_add(&bar[XB_XGEN(b.x)], 1u);
            asm volatile("s_waitcnt vmcnt(0)" ::: "memory");
        } else {
            XB_SPIN(xb_ld(&bar[XB_XGEN(b.x)]) == gen, bar);
            __builtin_amdgcn_fence(__ATOMIC_ACQUIRE, "agent");
            asm volatile("s_waitcnt vmcnt(0)" ::: "memory");
        }
    }
    __syncthreads();
}

__device__ __forceinline__ f32x4 ld4(const float* p) { return __builtin_nontemporal_load((const f32x4*)p); }
__device__ __forceinline__ f32x4 ld4(const bf16_t* p) { const u32x2 w = __builtin_nontemporal_load((const u32x2*)p);
    return (f32x4){bf_lo(w.x), bf_hi(w.x), bf_lo(w.y), bf_hi(w.y)}; }
__device__ __forceinline__ float wave_sum(float v) {
#pragma unroll
    for (int o = 1; o < 64; o <<= 1) v += __shfl_xor(v, o);
    return v;
}

__device__ __forceinline__ void transpose_item(const float* W, int K, int N, bf16_t* WT, int gmode, LAS float* scr, int item, int lane) {
    const int nblk = N / 64, kb = item / nblk, nb = item % nblk, k0 = 32 * kb, n0 = 64 * nb;
    const int rowbase = gmode < 0 ? n0 : (((gmode >> 1) * 2 + (n0 >> 7)) * 256 + (gmode & 1) * 128 + (n0 & 127));
    const float* src = W + (size_t)(k0 + (lane >> 4)) * N + n0 + 4 * (lane & 15);
    f32x4 v[8];
#pragma unroll
    for (int i = 0; i < 8; ++i) v[i] = *(const f32x4*)(src + (size_t)(4 * i) * N);
#pragma unroll
    for (int i = 0; i < 8; ++i) { LAS float* d = scr + ((lane >> 4) + 4 * i) * 65 + 4 * (lane & 15); d[0] = v[i].x; d[1] = v[i].y; d[2] = v[i].z; d[3] = v[i].w; }
    LDS_WAIT(); asm volatile("" ::: "memory");
    const int c = lane & 3;
#pragma unroll
    for (int j = 0; j < 4; ++j) { const int n = (lane >> 2) + 16 * j; const LAS float* s = scr + (8 * c) * 65 + n;
        u32x4 o; o.x = cvt_pk_bf16(s[0 * 65], s[1 * 65]); o.y = cvt_pk_bf16(s[2 * 65], s[3 * 65]); o.z = cvt_pk_bf16(s[4 * 65], s[5 * 65]); o.w = cvt_pk_bf16(s[6 * 65], s[7 * 65]);
        st16_wt(wt_rsrc(WT), (unsigned)((rowbase + n) * K + k0 + 8 * c) * 2u, o); }
    LDS_WAIT(); asm volatile("" ::: "memory");
}

struct Args {
    const float* in[24]; float* out; unsigned char* ws;
};

__device__ __forceinline__ void params_phase(const Args& a, float* PAR, int gtid, int gstride) {
#define CP_PAR(srci, off, n) for (int k = gtid; k < (n); k += gstride) PAR[(off) + k] = a.in[srci][k];
    CP_PAR(4, P_NMG, 4096) CP_PAR(5, P_NFG, 4096) CP_PAR(7, P_BY, 2048) CP_PAR(9, P_BIN, 2048) CP_PAR(10, P_CW, 8192) CP_PAR(11, P_CB, 2048) CP_PAR(13, P_BA, 2048) CP_PAR(15, P_BX, 2048)
    for (int k = gtid; k < 2048; k += gstride) PAR[P_LC + k] = -8.0f * log1pf(expf(-a.in[16][k]));
    CP_PAR(18, P_BOUT, 2048) CP_PAR(20, P_PS, 2048) CP_PAR(23, P_FG, 1024)
#undef CP_PAR
}
__device__ __forceinline__ void mod_phase(const float* c, const float* w_mod, const float* b_mod, float* MOD, LAS float* lf, int tid, int wave, int lane, int bid, int G) {
    for (int i = tid; i < NB * D; i += NTHR) { const float v = c[i]; lf[i] = v / (1.f + __expf(-v)); }
    __syncthreads();
    LAS float* part = lf + NB * D;
    for (int item = bid; item < 192; item += G) {
        const int layer = item / 48, cgp = item % 48;
        const float* wp = w_mod + (size_t)layer * D * 6144 + (size_t)(wave * 128) * 6144 + cgp * 128 + 2 * lane;
        float a[4][2];
#pragma unroll
        for (int b = 0; b < 4; ++b) { a[b][0] = 0.f; a[b][1] = 0.f; }
        for (int kk = 0; kk < 128; kk += 16) {
            f32x2 w[16];
#pragma unroll
            for (int q = 0; q < 16; ++q) w[q] = *(const f32x2*)(wp + (size_t)(kk + q) * 6144);
#pragma unroll
            for (int q = 0; q < 16; ++q) { const int k = wave * 128 + kk + q;
#pragma unroll
                for (int b = 0; b < 4; ++b) { const float cv = lf[b * D + k]; a[b][0] += cv * w[q].x; a[b][1] += cv * w[q].y; } }
        }
#pragma unroll
        for (int b = 0; b < 4; ++b) { part[(wave * 4 + b) * 128 + 2 * lane] = a[b][0]; part[(wave * 4 + b) * 128 + 2 * lane + 1] = a[b][1]; }
        __syncthreads();
        { const int b = tid >> 7, col = tid & 127; float s = 0.f;
#pragma unroll
          for (int w = 0; w < 8; ++w) s += part[(w * 4 + b) * 128 + col];
          const int gc = cgp * 128 + col; MOD[(size_t)(layer * 4 + b) * 6144 + gc] = s + b_mod[layer * 6144 + gc]; }
        __syncthreads();
    }
}

__device__ __forceinline__ void weights_phase(const Args& a, unsigned char* ws, LAS float* scr, int gw, int NGW, int lane) {
    constexpr int NIT = 16384 + 2 * 1920;
    for (int it = gw; it < NIT; it += NGW) {
        int r = it;
        if (r < 16384) { const int i = r >> 12; r &= 4095;
            if (r < 2048) transpose_item(a.in[21] + (size_t)i * D * FF, D, FF, (bf16_t*)(ws + WS_W1) + (size_t)i * D * FF, -1, scr, r, lane);
            else transpose_item(a.in[22] + (size_t)i * D * FF, FF, D, (bf16_t*)(ws + WS_W2) + (size_t)i * D * FF, -1, scr, r - 2048, lane);
        } else { r -= 16384; const int j = r / 1920; r %= 1920;
            bf16_t* wyi = (bf16_t*)(ws + WS_WYI) + (size_t)j * 2048 * 1024;
            if (r < 512) transpose_item(a.in[6] + (size_t)j * D * D, D, D, wyi, -1, scr, r, lane);
            else if (r < 1024) transpose_item(a.in[8] + (size_t)j * D * D, D, D, wyi + (size_t)1024 * 1024, -1, scr, r - 512, lane);
            else if (r < 1536) transpose_item(a.in[17] + (size_t)j * D * D, D, D, (bf16_t*)(ws + WS_WOUT) + (size_t)j * D * D, -1, scr, r - 1024, lane);
            else if (r < 1792) { r -= 1536; const int gt = r >> 7; r &= 127; const int h = r >> 5; r &= 31;
                transpose_item(a.in[gt ? 14 : 12] + (size_t)(j * 4 + h) * 65536, 256, 256, (bf16_t*)(ws + WS_WG) + (size_t)j * 2048 * 256, 2 * h + gt, scr, r, lane); }
            else { r -= 1792; const int gp = r >> 5; r &= 31;
                transpose_item(a.in[19] + (size_t)(j * 4 + gp) * 65536, 256, 256, (bf16_t*)(ws + WS_WPOOL) + (size_t)j * 1024 * 256 + (size_t)gp * 65536, -1, scr, r, lane); }
        }
    }
}

template <typename XT>
__device__ __forceinline__ void norm_phase(const XT* xs, bf16_t* H, bf16_t* xcopy  , const float* gvec, const float* modp, int gw, int NGW, int lane) {
    constexpr int NR = 4;
    const int rpw = (((T + NGW - 1) / NGW) + NR - 1) / NR * NR;
    const int r0 = gw * rpw, r1 = (r0 + rpw < T) ? r0 + rpw : T;
    int curb = -1; f32x4 Gv[4], Sv[4];
    for (int r = r0; r < r1; r += NR) {
        const int b = r / SEQ;
        if (b != curb) { curb = b;
#pragma unroll
            for (int j = 0; j < 4; ++j) { const int c = 256 * j + 4 * lane; const f32x4 g4 = *(const f32x4*)(gvec + c), sc = *(const f32x4*)(modp + b * 6144 + 1024 + c);
                Gv[j] = g4 * (sc + 1.0f); Sv[j] = *(const f32x4*)(modp + b * 6144 + c); } }
        const XT* x0 = xs + (size_t)r * D + 4 * lane;
        f32x4 v[NR][4]; float ss[NR];
#pragma unroll
        for (int q = 0; q < NR; ++q)
#pragma unroll
            for (int j = 0; j < 4; ++j) v[q][j] = ld4(x0 + (size_t)q * D + 256 * j);
        if (xcopy) {
#pragma unroll
            for (int q = 0; q < NR; ++q) { const __amdgpu_buffer_rsrc_t rc = wt_rsrc(xcopy); const unsigned cb = (unsigned)((r + q) * D + 4 * lane) * 2u;
#pragma unroll
                for (int j = 0; j < 4; ++j) st8_wt(rc, cb + 512u * j, (u32x2){cvt_pk_bf16(v[q][j].x, v[q][j].y), cvt_pk_bf16(v[q][j].z, v[q][j].w)}); } }
#pragma unroll
        for (int q = 0; q < NR; ++q) { float s = 0.f;
#pragma unroll
            for (int j = 0; j < 4; ++j) s += (v[q][j].x * v[q][j].x + v[q][j].y * v[q][j].y) + (v[q][j].z * v[q][j].z + v[q][j].w * v[q][j].w);
            ss[q] = s; }
#pragma unroll
        for (int o = 1; o < 64; o <<= 1) {
#pragma unroll
            for (int q = 0; q < NR; ++q) ss[q] += __shfl_xor(ss[q], o); }
#pragma unroll
        for (int q = 0; q < NR; ++q) { const float ri = rsqrtf(ss[q] * (1.f / D) + EPS); const __amdgpu_buffer_rsrc_t rh = wt_rsrc(H); const unsigned hbo = (unsigned)((r + q) * D + 4 * lane) * 2u;
#pragma unroll
            for (int j = 0; j < 4; ++j) { const f32x4 h0 = v[q][j] * ri * Gv[j] + Sv[j]; st8_wt(rh, hbo + 512u * j, (u32x2){cvt_pk_bf16(h0.x, h0.y), cvt_pk_bf16(h0.z, h0.w)}); } }
    }
}
__device__ __forceinline__ void final_norm_phase(const bf16_t* xs, float* out, const float* gvec, int gw, int NGW, int lane) {
    constexpr int NR = 4;
    f32x4 Gv[4];
#pragma unroll
    for (int j = 0; j < 4; ++j) Gv[j] = *(const f32x4*)(gvec + 256 * j + 4 * lane);
    for (int r = gw * NR; r < T; r += NGW * NR) {
        const bf16_t* x0 = xs + (size_t)r * D + 4 * lane;
        f32x4 v[NR][4]; float ss[NR];
#pragma unroll
        for (int q = 0; q < NR; ++q)
#pragma unroll
            for (int j = 0; j < 4; ++j) v[q][j] = ld4(x0 + (size_t)q * D + 256 * j);
#pragma unroll
        for (int q = 0; q < NR; ++q) { float s = 0.f;
#pragma unroll
            for (int j = 0; j < 4; ++j) s += (v[q][j].x * v[q][j].x + v[q][j].y * v[q][j].y) + (v[q][j].z * v[q][j].z + v[q][j].w * v[q][j].w);
            ss[q] = s; }
#pragma unroll
        for (int o = 1; o < 64; o <<= 1) {
#pragma unroll
            for (int q = 0; q < NR; ++q) ss[q] += __shfl_xor(ss[q], o); }
#pragma unroll
        for (int q = 0; q < NR; ++q) { const float ri = rsqrtf(ss[q] * (1.f / D) + EPS); f32x4* o0 = (f32x4*)(out + (size_t)(r + q) * D) + lane;
#pragma unroll
            for (int j = 0; j < 4; ++j) { const f32x4 y = v[q][j] * ri * Gv[j]; st16_wt(wt_rsrc(out), (unsigned)((r + q) * D + 256 * j + 4 * lane) * 4u, __builtin_bit_cast(u32x4, y)); } }
    }
}

__device__ __forceinline__ void pool_phase(const bf16_t* xs, bf16_t* H, const float* gvec, const float* modp, LAS unsigned* hb, int tid, int wave, int lane, int bid, int G) {
    constexpr int CH = 32, HALO = 15, ROWS = CH + HALO;
    for (int chunk = bid; chunk < T / CH; chunk += G) {
        const int t0 = chunk * CH, b = t0 / SEQ, tl0 = t0 - b * SEQ;
        f32x4 Gv[4], Sv[4];
#pragma unroll
        for (int j = 0; j < 4; ++j) { const int c = 256 * j + 4 * lane; const f32x4 g4 = *(const f32x4*)(gvec + c), sc = *(const f32x4*)(modp + b * 6144 + 1024 + c);
            Gv[j] = g4 * (sc + 1.0f); Sv[j] = *(const f32x4*)(modp + b * 6144 + c); }
        for (int rr0 = wave; rr0 < ROWS; rr0 += 3 * NWAVES) {
            f32x4 v0[3][4]; float s3[3];
#pragma unroll
            for (int q = 0; q < 3; ++q) { const int rr = rr0 + q * NWAVES; const bool ok = rr < ROWS && (tl0 - HALO + rr) >= 0;
                const bf16_t* x0 = xs + (size_t)(ok ? t0 - HALO + rr : t0) * D + 4 * lane;
#pragma unroll
                for (int j = 0; j < 4; ++j) v0[q][j] = ld4(x0 + 256 * j); }
#pragma unroll
            for (int q = 0; q < 3; ++q) { float s = 0.f;
#pragma unroll
                for (int j = 0; j < 4; ++j) s += (v0[q][j].x * v0[q][j].x + v0[q][j].y * v0[q][j].y) + (v0[q][j].z * v0[q][j].z + v0[q][j].w * v0[q][j].w);
                s3[q] = s; }
#pragma unroll
            for (int o = 1; o < 64; o <<= 1) {
#pragma unroll
                for (int q = 0; q < 3; ++q) s3[q] += __shfl_xor(s3[q], o); }
#pragma unroll
            for (int q = 0; q < 3; ++q) { const int rr = rr0 + q * NWAVES;
                if (rr < ROWS) { LAS u32x2* dst = (LAS u32x2*)(hb + rr * 512) + lane; const bool ok = (tl0 - HALO + rr) >= 0; const float ri0 = rsqrtf(s3[q] * (1.f / D) + EPS);
#pragma unroll
                    for (int j = 0; j < 4; ++j) { const f32x4 h0 = v0[q][j] * ri0 * Gv[j] + Sv[j]; dst[64 * j] = ok ? (u32x2){cvt_pk_bf16(h0.x, h0.y), cvt_pk_bf16(h0.z, h0.w)} : (u32x2){0u, 0u}; } } }
        }
        __syncthreads();
        {
            const int win = 2 << (tid >> 7);
            float s0 = 0.f, s1 = 0.f;
            for (int k = 1; k < win; ++k) { const unsigned w = hb[(HALO - k) * 512 + tid]; s0 += bf_lo(w); s1 += bf_hi(w); }
            const __amdgpu_buffer_rsrc_t rp = wt_rsrc(H); const unsigned pb = (unsigned)(t0 * D + 2 * tid) * 2u;
#pragma unroll 4
            for (int t = 0; t < CH; ++t) {
                const unsigned w = hb[(HALO + t) * 512 + tid]; const float h0 = bf_lo(w), h1 = bf_hi(w);
                s0 += h0; s1 += h1;
                const int cnt = (tl0 + t + 1 < win) ? (tl0 + t + 1) : win; const float ic = 1.0f / (float)cnt;
                st4_wt(rp, pb + (unsigned)t * 2048u, cvt_pk_bf16(s0 * ic - h0, s1 * ic - h1));
                const unsigned wo = hb[(HALO + t - win + 1) * 512 + tid]; s0 -= bf_lo(wo); s1 -= bf_hi(wo);
            }
        }
        __syncthreads();
    }
}

__device__ __forceinline__ void conv_phase(const bf16_t* XR, bf16_t* XC, const float* cw, const float* cb, int tid, int bid, int G) {
    constexpr int RG = 16;
    const int total = (T / RG) * 128;
    for (int it = bid * NTHR + tid; it < total; it += G * NTHR) {
        const int cg_ = it & 127, rg = it >> 7, t0 = rg * RG, tl0 = t0 & (SEQ - 1), c0 = cg_ * 8;
        f32x4 w[4][2], bb[2];
#pragma unroll
        for (int k = 0; k < 4; ++k) { w[k][0] = *(const f32x4*)(cw + k * D + c0); w[k][1] = *(const f32x4*)(cw + k * D + c0 + 4); }
        bb[0] = *(const f32x4*)(cb + c0); bb[1] = *(const f32x4*)(cb + c0 + 4);
        u32x4 rows[RG + 3];
#pragma unroll
        for (int q = 0; q < RG + 3; ++q) { if (q < 3 && tl0 == 0) rows[q] = (u32x4){0u, 0u, 0u, 0u}; else rows[q] = __builtin_nontemporal_load((const u32x4*)(XR + (size_t)(t0 - 3 + q) * D + c0)); }
#pragma unroll
        for (int t = 0; t < RG; ++t) {
            f32x4 o0 = bb[0], o1 = bb[1];
#pragma unroll
            for (int k = 0; k < 4; ++k) { const u32x4 v = rows[t + k];
                o0 += w[k][0] * (f32x4){bf_lo(v.x), bf_hi(v.x), bf_lo(v.y), bf_hi(v.y)}; o1 += w[k][1] * (f32x4){bf_lo(v.z), bf_hi(v.z), bf_lo(v.w), bf_hi(v.w)}; }
            st16_wt(wt_rsrc(XC), (unsigned)((t0 + t) * D + c0) * 2u, (u32x4){cvt_pk_bf16(o0.x, o0.y), cvt_pk_bf16(o0.z, o0.w), cvt_pk_bf16(o1.x, o1.y), cvt_pk_bf16(o1.z, o1.w)});
        }
    }
}

__device__ __forceinline__ void scan1_phase(const bf16_t* LOGA, const bf16_t* UU, float* AGA, float* AGH, int tid, int bid, int G) {
    for (int ch = bid; ch < NCHUNK; ch += G) {
        const unsigned* la = (const unsigned*)(LOGA + (size_t)ch * LC * D) + tid; const unsigned* up = (const unsigned*)(UU + (size_t)ch * LC * D) + tid;
        float A0 = 0.f, A1 = 0.f, h0 = 0.f, h1 = 0.f;
        for (int t = 0; t < LC; t += 32) {
            unsigned l[32], u[32];
#pragma unroll
            for (int q = 0; q < 32; ++q) { l[q] = __builtin_nontemporal_load(la + (size_t)(t + q) * 512); u[q] = __builtin_nontemporal_load(up + (size_t)(t + q) * 512); }
#pragma unroll
            for (int q = 0; q < 32; ++q) { const float l0 = bf_lo(l[q]), l1 = bf_hi(l[q]); A0 += l0; A1 += l1;
                h0 = __expf(l0) * h0 + bf_lo(u[q]); h1 = __expf(l1) * h1 + bf_hi(u[q]); }
        }
        st8_wt(wt_rsrc(AGA), (unsigned)(ch * D + 2 * tid) * 4u, (u32x2){__float_as_uint(A0), __float_as_uint(A1)}); st8_wt(wt_rsrc(AGH), (unsigned)(ch * D + 2 * tid) * 4u, (u32x2){__float_as_uint(h0), __float_as_uint(h1)});
    }
}
__device__ __forceinline__ void scan2_phase(const float* AGA, const float* AGH, float* CAR, int wave, int lane, int bid) {
    if (wave != 0 || bid >= 64) return;
    const int b = bid >> 4, c = (bid & 15) * 64 + lane;
    const size_t base = (size_t)b * (SEQ / LC) * D + c;
    float carry = 0.f;
    for (int k = 0; k < SEQ / LC; k += 32) {
        float av[32], hv[32];
#pragma unroll
        for (int q = 0; q < 32; ++q) { av[q] = AGA[base + (size_t)(k + q) * D]; hv[q] = AGH[base + (size_t)(k + q) * D]; }
#pragma unroll
        for (int q = 0; q < 32; ++q) { st4_wt(wt_rsrc(CAR), (unsigned)(base + (size_t)(k + q) * D) * 4u, __float_as_uint(carry)); carry = __expf(av[q]) * carry + hv[q]; }
    }
}
__device__ __forceinline__ void scan3_phase(const bf16_t* LOGA, const bf16_t* UU, const bf16_t* GATE, const float* CAR, bf16_t* HG, int tid, int bid, int G) {
    for (int ch = bid; ch < NCHUNK; ch += G) {
        const size_t ro = (size_t)ch * LC * D;
        const unsigned* la = (const unsigned*)(LOGA + ro) + tid; const unsigned* up = (const unsigned*)(UU + ro) + tid; const unsigned* gp = (const unsigned*)(GATE + ro) + tid;
        const __amdgpu_buffer_rsrc_t rg3 = wt_rsrc(HG); const unsigned ob = (unsigned)(ro + 2 * tid) * 2u;
        const f32x2 cv = *(const f32x2*)(CAR + (size_t)ch * D + 2 * tid);
        float h0 = cv.x, h1 = cv.y;
        for (int t = 0; t < LC; t += 32) {
            unsigned l[32], u[32], g[32];
#pragma unroll
            for (int q = 0; q < 32; ++q) { l[q] = __builtin_nontemporal_load(la + (size_t)(t + q) * 512); u[q] = __builtin_nontemporal_load(up + (size_t)(t + q) * 512); g[q] = __builtin_nontemporal_load(gp + (size_t)(t + q) * 512); }
#pragma unroll
            for (int q = 0; q < 32; ++q) { h0 = __expf(bf_lo(l[q])) * h0 + bf_lo(u[q]); h1 = __expf(bf_hi(l[q])) * h1 + bf_hi(u[q]);
                st4_wt(rg3, ob + (unsigned)(t + q) * 2048u, cvt_pk_bf16(h0 * bf_lo(g[q]), h1 * bf_hi(g[q]))); }
        }
    }
}

__global__ void __launch_bounds__(NTHR, 2) fwd_megakernel(Args args) {
    extern __shared__ __attribute__((aligned(16))) unsigned char lds[];
    LAS unsigned char* L = (LAS unsigned char*)lds;
    volatile LAS unsigned* MISC = (volatile LAS unsigned*)(L + MISC_OFF);
    int G = gridDim.x, bid = blockIdx.x, NGW = G * NWAVES;
    int tid = threadIdx.x, lane = tid & 63, wave = __builtin_amdgcn_readfirstlane(tid >> 6), gw = bid * NWAVES + wave;
#define FRESH_TID() do { G = gridDim.x; bid = blockIdx.x; asm volatile("" : "+s"(G), "+s"(bid)); NGW = G * NWAVES; tid = threadIdx.x; asm volatile("" : "+v"(tid)); lane = tid & 63; wave = __builtin_amdgcn_readfirstlane(tid >> 6); gw = bid * NWAVES + wave; } while (0)
    unsigned char* ws = args.ws;
    if (tid < 64) MISC[tid] = 0u;
    __syncthreads();
    (void)xcd_barrier_post((unsigned*)(ws + WS_CTL), MISC + 8);
#define GRID_BAR() do { ws = args.ws; asm volatile("" : "+s"(ws)); xcd_barrier((unsigned*)(ws + WS_CTL), MISC + 8); } while (0)

#define MOD ((float*)(ws + WS_MOD))
#define PAR ((float*)(ws + WS_PAR))
#define Hb ((bf16_t*)(ws + WS_H))
#define Ub ((bf16_t*)(ws + WS_U))
#define GATE ((bf16_t*)(ws + WS_GATE))
#define XR ((bf16_t*)(ws + WS_XR))
#define XC ((bf16_t*)(ws + WS_XC))
#define LOGA ((bf16_t*)(ws + WS_LOGA))
#define UU Hb
#define HG XR
#define Xb ((bf16_t*)(ws + WS_XB))
#define AGA ((float*)(ws + WS_AGA))
#define AGH ((float*)(ws + WS_AGH))
#define CAR ((float*)(ws + WS_CAR))
#define modL (MOD + (size_t)i * 4 * 6144)
    float* X = args.out;
#define FRESH() do { ws = args.ws; X = args.out; asm volatile("" : "+s"(ws), "+s"(X)); FRESH_TID(); } while (0)

    params_phase(args, PAR, bid * NTHR + tid, G * NTHR);
    FRESH(); mod_phase(args.in[1], args.in[2], args.in[3], MOD, (LAS float*)L, tid, wave, lane, bid, G);
    __syncthreads();
    FRESH(); weights_phase(args, ws, (LAS float*)(L + wave * 16384), gw, NGW, lane);
    if (args.ws == nullptr) cg::this_grid().sync();
    GRID_BAR();

    for (int i = 0; i < DEPTH; ++i) {
        const int j = i >> 1;
        if ((i & 1) == 0) {
            FRESH(); if (i == 0) norm_phase<float>(args.in[0], Hb, Xb, PAR + P_NMG + i * D, modL, gw, NGW, lane);
            else norm_phase<bf16_t>(Xb, Hb, nullptr, PAR + P_NMG + i * D, modL, gw, NGW, lane);
            GRID_BAR();
            FRESH(); { pg8::Gemm g{Hb, (const bf16_t*)(ws + WS_WYI) + (size_t)j * 2048 * 1024, T, 2048, D, D, -1}; pg8::StaticOrder S; S.init(T, 2048, G, bid);
              pg8::EpiG1 E{GATE, XR, PAR + P_BY + j * D, PAR + P_BIN + j * D};
              pg8::gemm_phase<pg8::EpiG1, pg8::StaticOrder>(L, g, S, E); }
            GRID_BAR();
            FRESH(); conv_phase(XR, XC, PAR + P_CW + j * 4 * D, PAR + P_CB + j * D, tid, bid, G);
            GRID_BAR();
            FRESH(); { pg8::Gemm g{XC, (const bf16_t*)(ws + WS_WG) + (size_t)j * 2048 * 256, T, 2048, 256, D, 1}; pg8::StaticOrder S; S.init(T, 2048, G, bid);
              pg8::EpiGates E{XC, LOGA, UU, PAR + P_BA + j * D, PAR + P_BX + j * D, PAR + P_LC + j * D};
              pg8::gemm_phase<pg8::EpiGates, pg8::StaticOrder>(L, g, S, E); }
            GRID_BAR();
            FRESH(); scan1_phase(LOGA, UU, AGA, AGH, tid, bid, G);
            GRID_BAR();
            FRESH(); scan2_phase(AGA, AGH, CAR, wave, lane, bid);
            GRID_BAR();
            FRESH(); scan3_phase(LOGA, UU, GATE, CAR, HG, tid, bid, G);
            GRID_BAR();
            FRESH(); { pg8::Gemm g{HG, (const bf16_t*)(ws + WS_WOUT) + (size_t)j * D * D, T, D, D, D, -1}; pg8::StaticOrder S; S.init(T, D, G, bid);
              pg8::EpiXUpd E{Xb, Xb, modL + 2048, PAR + P_BOUT + j * D, nullptr};
              pg8::gemm_phase<pg8::EpiXUpd, pg8::StaticOrder>(L, g, S, E); }
            GRID_BAR();
        } else {
            FRESH(); pool_phase(Xb, Hb, PAR + P_NMG + i * D, modL, (LAS unsigned*)L, tid, wave, lane, bid, G);
            GRID_BAR();
            FRESH(); { pg8::Gemm g{Hb, (const bf16_t*)(ws + WS_WPOOL) + (size_t)j * 1024 * 256, T, D, 256, D, 0}; pg8::StaticOrder S; S.init(T, D, G, bid);
              pg8::EpiXUpd E{Xb, Xb, modL + 2048, nullptr, PAR + P_PS + j * D};
              pg8::gemm_phase<pg8::EpiXUpd, pg8::StaticOrder>(L, g, S, E); }
            GRID_BAR();
        }
        FRESH(); norm_phase<bf16_t>(Xb, Hb, nullptr, PAR + P_NFG + i * D, modL + 3072, gw, NGW, lane);
        GRID_BAR();
        FRESH(); { pg8::Gemm g{Hb, (const bf16_t*)(ws + WS_W1) + (size_t)i * D * FF, T, FF, D, D, -1}; pg8::StaticOrder S; S.init(T, FF, G, bid);
          pg8::EpiFF1 E{Ub};
          pg8::gemm_phase<pg8::EpiFF1, pg8::StaticOrder>(L, g, S, E); }
        GRID_BAR();
        FRESH(); { pg8::Gemm g{Ub, (const bf16_t*)(ws + WS_W2) + (size_t)i * D * FF, T, D, FF, FF, -1}; pg8::StaticOrder S; S.init(T, D, G, bid, 8);
          pg8::EpiXUpd E{Xb, Xb, modL + 5120, nullptr, nullptr};
          pg8::gemm_phase<pg8::EpiXUpd, pg8::StaticOrder>(L, g, S, E); }
        GRID_BAR();
    }
    FRESH(); final_norm_phase(Xb, X, PAR + P_FG, gw, NGW, lane);
}

extern "C" void kernel_launch(void* const* d_in, const int* in_sizes, int n_in, void* d_out, int out_size, void* d_ws, size_t ws_size, hipStream_t stream) {
    static int grid = 0;
    if (grid == 0) {
        if (n_in != 24 || in_sizes[0] != T * D || out_size != T * D || ws_size < WS_END) { fprintf(stderr, "kernel_launch: unexpected shapes (n_in %d, in0 %d, out %d, ws %zu); nothing launched\n", n_in, n_in > 0 ? in_sizes[0] : -1, out_size, ws_size); grid = -1; return; }
        int dev = 0, cus = 0, per_cu = 0;
        if (hipGetDevice(&dev) != hipSuccess || hipDeviceGetAttribute(&cus, hipDeviceAttributeMultiprocessorCount, dev) != hipSuccess) { grid = -1; return; }
        if (hipFuncSetAttribute((const void*)fwd_megakernel, hipFuncAttributeMaxDynamicSharedMemorySize, LDS_BYTES) != hipSuccess) { fprintf(stderr, "kernel_launch: hipFuncSetAttribute failed\n"); grid = -1; return; }
        if (hipOccupancyMaxActiveBlocksPerMultiprocessor(&per_cu, (const void*)fwd_megakernel, NTHR, LDS_BYTES) != hipSuccess || per_cu < 1) { fprintf(stderr, "kernel_launch: occupancy query says %d blocks per CU\n", per_cu); per_cu = 1; }
        (void)hipGetLastError();
        grid = cus;
    }
    if (grid < 0) return;
    (void)hipMemsetAsync((char*)d_ws + WS_CTL, 0, CTL_ZERO_BYTES, stream);
    Args a{};
    for (int i = 0; i < 24; ++i) a.in[i] = (const float*)d_in[i];
    a.out = (float*)d_out; a.ws = (unsigned char*)d_ws;
    void* kargs[] = {&a};
    hipError_t e = hipLaunchCooperativeKernel((const void*)fwd_megakernel, dim3(grid), dim3(NTHR), kargs, LDS_BYTES, stream);
    if (e != hipSuccess) fprintf(stderr, "kernel_launch: cooperative launch failed: %s (grid %d)\n", hipGetErrorString(e), grid);
}
```

```cpp
#include <hip/hip_runtime.h>
#include <hip/hip_cooperative_groups.h>
#include <cstdio>
#include <cstdint>
namespace cg = cooperative_groups;

namespace pg8 {
#define PG8_LAS __attribute__((address_space(3)))
typedef unsigned short bf16_t;
typedef short bf16x8 __attribute__((ext_vector_type(8)));
typedef float f32x4 __attribute__((ext_vector_type(4)));
typedef float f32x2 __attribute__((ext_vector_type(2)));
typedef unsigned u32x4 __attribute__((ext_vector_type(4)));
typedef unsigned u32x2 __attribute__((ext_vector_type(2)));
constexpr int BM = 256, BK = 64, HALF = 128, HTB = HALF * BK * 2, STAGE_BYTES = 8 * HTB, NXCD = 8, WGM = 8;

__host__ __device__ __forceinline__ int lds_byte(int r, int c) { const int st = (r >> 4) * 2 + (c >> 5), rr = r & 15, cc = c & 31, ob = rr * 64 + cc * 2; return st * 1024 + (ob ^ (((ob >> 9) & 1) << 5)); }
__host__ __device__ __forceinline__ void stage_rc(int b, int& R, int& C) { const int st = b / 1024, sb = b % 1024, swz = sb ^ (((sb >> 9) & 1) << 5); R = (st >> 1) * 16 + swz / 64; C = (st & 1) * 32 + (swz % 64) / 2; }
__host__ __device__ __forceinline__ int perm32(int rho) { const int n = rho >> 4, i = rho & 15; return 8 * (i >> 2) + 4 * n + (i & 3); }

struct Unit { int pm, pn; };
struct Gemm { const bf16_t* A; const bf16_t* Bt; int M, N, K, lda, gshift; };

struct StaticOrder {
    int nM, nN, nwg, G, c, flip;
    __host__ __device__ void init(int M, int N, int G_, int c_, int flip_ = 0) { nM = M / BM; nN = N / BM; nwg = nM * nN; G = G_; c = c_; flip = flip_; }
    __host__ __device__ bool next(int i, Unit& u) const {
        const long L = (long)i * G + c; if (L >= nwg) return false;
        int wgid = (int)L; { const int q = nwg / NXCD, r = nwg % NXCD, xcd = wgid % NXCD, off = wgid / NXCD; wgid = (xcd < r ? xcd * (q + 1) : r * (q + 1) + (xcd - r) * q) + off; }
        const int nig = WGM * nN, gid = wgid / nig, fm = gid * WGM, gsz = (nM - fm) < WGM ? (nM - fm) : WGM;
        u.pm = (fm + ((wgid % nig) % gsz)) ^ flip; u.pn = (wgid % nig) / gsz; return true;
    }
};

__device__ __forceinline__ unsigned cvt_pk_bf16(float lo, float hi) { unsigned r; asm volatile("v_cvt_pk_bf16_f32 %0, %1, %2" : "=v"(r) : "v"(lo), "v"(hi)); return r; }
__device__ __forceinline__ __amdgpu_buffer_rsrc_t wt_rsrc(const void* p) { return __builtin_amdgcn_make_buffer_rsrc((void*)p, (short)0, 0x7ffff000, 0x00020000); }
__device__ __forceinline__ void st16_wt(__amdgpu_buffer_rsrc_t rs, unsigned byte_off, u32x4 v) { __builtin_amdgcn_raw_buffer_store_b128(v, rs, (int)byte_off, 0,   16); }
__device__ __forceinline__ void st8_wt(__amdgpu_buffer_rsrc_t rs, unsigned byte_off, u32x2 v) { __builtin_amdgcn_raw_buffer_store_b64(v, rs, (int)byte_off, 0, 16); }
__device__ __forceinline__ void st4_wt(__amdgpu_buffer_rsrc_t rs, unsigned byte_off, unsigned v) { __builtin_amdgcn_raw_buffer_store_b32(v, rs, (int)byte_off, 0, 16); }
__device__ __forceinline__ float bf_lo(unsigned w) { return __uint_as_float(w << 16); }
__device__ __forceinline__ float bf_hi(unsigned w) { return __uint_as_float(w & 0xffff0000u); }
__device__ __forceinline__ float fast_sigmoid(float z) { return __builtin_amdgcn_rcpf(1.0f + __builtin_amdgcn_exp2f(-1.4426950408889634f * z)); }
__device__ __forceinline__ float gelu_tanh(float v) { const float a = 1.5957691216057308f * (v + 0.044715f * v * v * v); return v * fast_sigmoid(a); }


struct EpiG1 {
    static constexpr bool PERM = true;
    bf16_t* gate; bf16_t* xr; const float* b_y; const float* b_in;
    __device__ __forceinline__ void operator()(const f32x4 (&acc)[2][2][4][2], const Unit& u, int wr, int wc, int fr, int fq) const {
        const int row0 = u.pm * BM + wr * 64 + fr; int colt = u.pn * BM; const bool isg = colt < 1024;
        bf16_t* base = isg ? gate : xr; const __amdgpu_buffer_rsrc_t rs = wt_rsrc(base); const float* bias = isg ? b_y : b_in; if (!isg) colt -= 1024;
        const int col0 = colt + wc * 32 + 8 * fq;
        f32x4 bv[2][2];
#pragma unroll
        for (int bj = 0; bj < 2; ++bj)
#pragma unroll
            for (int n = 0; n < 2; ++n) bv[bj][n] = *(const f32x4*)(bias + col0 + bj * HALF + 4 * n);
#pragma unroll
        for (int ai = 0; ai < 2; ++ai)
#pragma unroll
            for (int m = 0; m < 4; ++m) { const unsigned rowb = (unsigned)((row0 + ai * HALF + m * 16) * 1024 + col0) * 2u;
#pragma unroll
                for (int bj = 0; bj < 2; ++bj) { f32x4 v0 = acc[ai][bj][m][0] + bv[bj][0], v1 = acc[ai][bj][m][1] + bv[bj][1];
                    if (isg) { v0 = (f32x4){gelu_tanh(v0[0]), gelu_tanh(v0[1]), gelu_tanh(v0[2]), gelu_tanh(v0[3])}; v1 = (f32x4){gelu_tanh(v1[0]), gelu_tanh(v1[1]), gelu_tanh(v1[2]), gelu_tanh(v1[3])}; }
                    u32x4 w; w.x = cvt_pk_bf16(v0[0], v0[1]); w.y = cvt_pk_bf16(v0[2], v0[3]); w.z = cvt_pk_bf16(v1[0], v1[1]); w.w = cvt_pk_bf16(v1[2], v1[3]);
                    st16_wt(rs, rowb + bj * HALF * 2, w); } }
    }
};
struct EpiFF1 {
    static constexpr bool PERM = true;
    bf16_t* O;
    __device__ __forceinline__ void operator()(const f32x4 (&acc)[2][2][4][2], const Unit& u, int wr, int wc, int fr, int fq) const {
        const int row0 = u.pm * BM + wr * 64 + fr; const int col0 = u.pn * BM + wc * 32 + 8 * fq;
        const __amdgpu_buffer_rsrc_t rs = wt_rsrc(O);
#pragma unroll
        for (int ai = 0; ai < 2; ++ai)
#pragma unroll
            for (int m = 0; m < 4; ++m) { const unsigned rowb = (unsigned)((row0 + ai * HALF + m * 16) * 4096 + col0) * 2u;
#pragma unroll
                for (int bj = 0; bj < 2; ++bj) { f32x4 v0 = acc[ai][bj][m][0], v1 = acc[ai][bj][m][1];
#pragma unroll
                    for (int j = 0; j < 4; ++j) { float a = fmaxf(v0[j], 0.f); v0[j] = a * a; float b = fmaxf(v1[j], 0.f); v1[j] = b * b; }
                    u32x4 w; w.x = cvt_pk_bf16(v0[0], v0[1]); w.y = cvt_pk_bf16(v0[2], v0[3]); w.z = cvt_pk_bf16(v1[0], v1[1]); w.w = cvt_pk_bf16(v1[2], v1[3]);
                    st16_wt(rs, rowb + bj * HALF * 2, w); } }
    }
};
struct EpiGates {
    static constexpr bool PERM = true;
    const bf16_t* xc; bf16_t* loga; bf16_t* uu; const float* b_a; const float* b_x; const float* lcp;
    __device__ __forceinline__ void operator()(f32x4 (&acc)[2][2][4][2], const Unit& u, int wr, int wc, int fr, int fq) const {
        const int head = u.pn >> 1, half = u.pn & 1;
        const int ch0 = head * 256 + half * 128 + wc * 32 + 8 * fq;
        const __amdgpu_buffer_rsrc_t rsl = wt_rsrc(loga), rsu = wt_rsrc(uu);
#pragma unroll
        for (int n = 0; n < 2; ++n) {
            const f32x4 ba = *(const f32x4*)(b_a + ch0 + 4 * n), lc = *(const f32x4*)(lcp + ch0 + 4 * n);
#pragma unroll
            for (int ai = 0; ai < 2; ++ai)
#pragma unroll
                for (int m = 0; m < 4; ++m)
#pragma unroll
                    for (int j = 0; j < 4; ++j) acc[ai][0][m][n][j] = lc[j] * fast_sigmoid(acc[ai][0][m][n][j] + ba[j]);
        }
#pragma unroll
        for (int n = 0; n < 2; ++n) {
            const f32x4 bx = *(const f32x4*)(b_x + ch0 + 4 * n);
#pragma unroll
            for (int ai = 0; ai < 2; ++ai)
#pragma unroll
                for (int m = 0; m < 4; ++m)
#pragma unroll
                    for (int j = 0; j < 4; ++j) { const float x2 = 2.0f * acc[ai][0][m][n][j];
                        const float big = 1.0f - __builtin_amdgcn_exp2f(1.4426950408889634f * x2), small = -x2 * (1.0f + x2 * (0.5f + x2 * 0.16666667f));
                        const float m2 = x2 > -0.01f ? small : big;
                        acc[ai][1][m][n][j] = __builtin_amdgcn_sqrtf(fmaxf(m2, 0.f)) * fast_sigmoid(acc[ai][1][m][n][j] + bx[j]); }
        }
        u32x4 xvv[2][4];
#pragma unroll
        for (int ai = 0; ai < 2; ++ai)
#pragma unroll
            for (int m = 0; m < 4; ++m) xvv[ai][m] = *(const u32x4*)(xc + (size_t)(u.pm * BM + ai * HALF + wr * 64 + m * 16 + fr) * 1024 + ch0);
#pragma unroll
        for (int ai = 0; ai < 2; ++ai)
#pragma unroll
            for (int m = 0; m < 4; ++m) { const size_t off = (size_t)(u.pm * BM + ai * HALF + wr * 64 + m * 16 + fr) * 1024 + ch0;
                const u32x4 xv = xvv[ai][m];
                const f32x4 l0 = acc[ai][0][m][0], l1 = acc[ai][0][m][1], g0 = acc[ai][1][m][0], g1 = acc[ai][1][m][1];
                u32x4 wl, wu;
                wl.x = cvt_pk_bf16(l0[0], l0[1]); wl.y = cvt_pk_bf16(l0[2], l0[3]); wl.z = cvt_pk_bf16(l1[0], l1[1]); wl.w = cvt_pk_bf16(l1[2], l1[3]);
                wu.x = cvt_pk_bf16(g0[0] * bf_lo(xv.x), g0[1] * bf_hi(xv.x)); wu.y = cvt_pk_bf16(g0[2] * bf_lo(xv.y), g0[3] * bf_hi(xv.y));
                wu.z = cvt_pk_bf16(g1[0] * bf_lo(xv.z), g1[1] * bf_hi(xv.z)); wu.w = cvt_pk_bf16(g1[2] * bf_lo(xv.w), g1[3] * bf_hi(xv.w));
                st16_wt(rsl, (unsigned)off * 2u, wl); st16_wt(rsu, (unsigned)off * 2u, wu);
                if (m & 1) asm volatile("" ::: "memory"); }
    }
};
struct EpiXUpd {
    static constexpr bool PERM = true;
    const bf16_t* base; bf16_t* out; const float* gt;   const float* bias; const float* ps;
    __device__ __forceinline__ void operator()(const f32x4 (&acc)[2][2][4][2], const Unit& u, int wr, int wc, int fr, int fq) const {
        const int b = u.pm >> 5; const float* gtp = gt + b * 6144;
        const int col0 = u.pn * BM + wc * 32 + 8 * fq;
        const __amdgpu_buffer_rsrc_t rso = wt_rsrc(out);
        f32x4 mul[2][2], add[2][2];
#pragma unroll
        for (int bj = 0; bj < 2; ++bj)
#pragma unroll
            for (int n = 0; n < 2; ++n) { const int c = col0 + bj * HALF + 4 * n; const f32x4 g4 = *(const f32x4*)(gtp + c);
                mul[bj][n] = ps ? g4 * *(const f32x4*)(ps + c) : g4; add[bj][n] = bias ? g4 * *(const f32x4*)(bias + c) : (f32x4){0.f, 0.f, 0.f, 0.f}; }
#pragma unroll
        for (int ai = 0; ai < 2; ++ai) {
            u32x4 bwv[4][2];
#pragma unroll
            for (int m = 0; m < 4; ++m)
#pragma unroll
                for (int bj = 0; bj < 2; ++bj) bwv[m][bj] = *(const u32x4*)(base + (size_t)(u.pm * BM + ai * HALF + wr * 64 + m * 16 + fr) * 1024 + col0 + bj * HALF);
            asm volatile("" ::: "memory");
#pragma unroll
            for (int m = 0; m < 4; ++m) { const size_t off = (size_t)(u.pm * BM + ai * HALF + wr * 64 + m * 16 + fr) * 1024 + col0;
#pragma unroll
                for (int bj = 0; bj < 2; ++bj) { const u32x4 bw = bwv[m][bj];
                    const f32x4 v0 = (f32x4){bf_lo(bw.x), bf_hi(bw.x), bf_lo(bw.y), bf_hi(bw.y)} + acc[ai][bj][m][0] * mul[bj][0] + add[bj][0];
                    const f32x4 v1 = (f32x4){bf_lo(bw.z), bf_hi(bw.z), bf_lo(bw.w), bf_hi(bw.w)} + acc[ai][bj][m][1] * mul[bj][1] + add[bj][1];
                    st16_wt(rso, (unsigned)(off + bj * HALF) * 2u, (u32x4){cvt_pk_bf16(v0[0], v0[1]), cvt_pk_bf16(v0[2], v0[3]), cvt_pk_bf16(v1[0], v1[1]), cvt_pk_bf16(v1[2], v1[3])}); } }
            asm volatile("" ::: "memory");
        }
    }
};

template <class Epi, class Sched>
__device__ __forceinline__ void gemm_phase(PG8_LAS unsigned char* lds, const Gemm g, const Sched& S, const Epi& E) {
    int tid = threadIdx.x; asm volatile("" : "+v"(tid));
    const int wid = __builtin_amdgcn_readfirstlane(tid >> 6), lane = tid & 63, wr = wid >> 2, wc = wid & 3, fr = lane & 15, fq = lane >> 4;
    const int K = g.K, nt = K / BK, lda = g.lda;
    unsigned voffA[2], voffB[2];
#pragma unroll
    for (int i = 0; i < 2; ++i) { int R, C; stage_rc(tid * 16 + i * 8192, R, C); const int Rb = Epi::PERM ? ((R & ~31) + perm32(R & 31)) : R;
        voffA[i] = (unsigned)(R * lda + C) * 2u; voffB[i] = (unsigned)(Rb * K + C) * 2u; }
    const unsigned kstep = (unsigned)(BK * 2);
    const unsigned hstepA = (unsigned)HALF * lda * 2u, hstepB = (unsigned)HALF * K * 2u;
    const unsigned tstepA = 2u * hstepA, tstepB = 2u * hstepB;
    const __amdgpu_buffer_rsrc_t rsA = __builtin_amdgcn_make_buffer_rsrc((void*)g.A, (short)0, 0x7ffff000, 0x00020000);
    const __amdgpu_buffer_rsrc_t rsB = __builtin_amdgcn_make_buffer_rsrc((void*)g.Bt, (short)0, 0x7ffff000, 0x00020000);
    const unsigned ldsw = (unsigned)wid * 1024u;
    const int aoff = lds_byte(wr * 64 + fr, fq * 8), boff = lds_byte(wc * 32 + fr, fq * 8);
#define PG8_SA(b, h) (((b) * 2 + (h)) * HTB)
#define PG8_SB(b, h) ((4 + (b) * 2 + (h)) * HTB)
#define PG8_STAGE(bufoff, rs, soff, voff) do { _Pragma("unroll") for (int _i = 0; _i < 2; ++_i) \
        __builtin_amdgcn_raw_ptr_buffer_load_lds(rs, (PG8_LAS unsigned*)(lds + (bufoff) + ldsw + _i * 8192), 16, (int)(voff)[_i], (int)(soff), 0, 0); } while (0)
#define PG8_LDA(dst, b, h) do { _Pragma("unroll") for (int m = 0; m < 4; ++m) _Pragma("unroll") for (int k = 0; k < 2; ++k) dst[m][k] = *(const PG8_LAS bf16x8*)(lds + PG8_SA(b, h) + aoff + m * 2048 + k * 1024); } while (0)
#define PG8_LDB(dst, b, h) do { _Pragma("unroll") for (int n = 0; n < 2; ++n) _Pragma("unroll") for (int k = 0; k < 2; ++k) dst[n][k] = *(const PG8_LAS bf16x8*)(lds + PG8_SB(b, h) + boff + n * 2048 + k * 1024); } while (0)
#define PG8_MMA(ai, bj, At, Bt) do { __builtin_amdgcn_s_setprio(1); _Pragma("unroll") for (int m = 0; m < 4; ++m) _Pragma("unroll") for (int n = 0; n < 2; ++n) _Pragma("unroll") for (int k = 0; k < 2; ++k) \
        acc[ai][bj][m][n] = __builtin_amdgcn_mfma_f32_16x16x32_bf16(Bt[n][k], At[m][k], acc[ai][bj][m][n], 0, 0, 0); __builtin_amdgcn_s_setprio(0); } while (0)
#define PG8_WAIT_V(n) asm volatile("s_waitcnt vmcnt(" #n ")" ::: "memory")
#define PG8_WAIT_L(n) asm volatile("s_waitcnt lgkmcnt(" #n ")" ::: "memory")
#define PG8_BAR __builtin_amdgcn_s_barrier()
#define PG8_SCHED __builtin_amdgcn_sched_barrier(0)
#define PG8_APTR(u) ((unsigned)(u).pm * tstepA + (g.gshift >= 0 ? (unsigned)(((u).pn >> g.gshift) * K) * 2u : 0u))
    Unit cur, nxt; int ui = 0;
    if (!S.next(0, cur)) return;
    f32x4 acc[2][2][4][2];
#pragma unroll
    for (int a = 0; a < 2; ++a)
#pragma unroll
        for (int b = 0; b < 2; ++b)
#pragma unroll
            for (int m = 0; m < 4; ++m)
#pragma unroll
                for (int n = 0; n < 2; ++n) acc[a][b][m][n] = (f32x4){0.f, 0.f, 0.f, 0.f};
    bf16x8 At[4][2], B0[2][2], B1[2][2];
    unsigned cA = PG8_APTR(cur), cB = (unsigned)cur.pn * tstepB;
    PG8_STAGE(PG8_SB(0, 0), rsB, cB, voffB); PG8_STAGE(PG8_SB(0, 1), rsB, cB + hstepB, voffB); PG8_STAGE(PG8_SA(0, 0), rsA, cA, voffA); PG8_STAGE(PG8_SA(0, 1), rsA, cA + hstepA, voffA);
    if (wr == 1) PG8_BAR;
    PG8_WAIT_V(2); PG8_BAR;
    PG8_STAGE(PG8_SB(1, 0), rsB, cB + kstep, voffB); PG8_STAGE(PG8_SA(1, 0), rsA, cA + kstep, voffA); PG8_STAGE(PG8_SB(1, 1), rsB, cB + hstepB + kstep, voffB);
    PG8_WAIT_V(6); PG8_BAR;
    for (;;) {
        const bool has_next = S.next(ui + 1, nxt);
        const unsigned nA = has_next ? PG8_APTR(nxt) : cA, nB = has_next ? (unsigned)nxt.pn * tstepB : cB;
        for (int t = 0; t < nt; t += 2) {
            const bool last = (t == nt - 2);
            const unsigned a1 = cA + (unsigned)(t + 1) * kstep;
            const unsigned a2 = last ? nA : cA + (unsigned)(t + 2) * kstep, b2 = last ? nB : cB + (unsigned)(t + 2) * kstep;
            const unsigned a3 = a2 + kstep, b3 = b2 + kstep;
            PG8_LDB(B0, 0, 0); PG8_LDB(B1, 0, 1); PG8_SCHED; PG8_LDA(At, 0, 0); PG8_STAGE(PG8_SA(1, 1), rsA, a1 + hstepA, voffA);
            PG8_WAIT_V(8); PG8_WAIT_L(0); PG8_BAR; PG8_MMA(0, 0, At, B0); PG8_MMA(0, 1, At, B1); PG8_BAR; PG8_SCHED;
            PG8_LDA(At, 0, 1); PG8_STAGE(PG8_SB(0, 0), rsB, b2, voffB); PG8_STAGE(PG8_SB(0, 1), rsB, b2 + hstepB, voffB); PG8_STAGE(PG8_SA(0, 0), rsA, a2, voffA);
            PG8_WAIT_V(8); PG8_WAIT_L(0); PG8_BAR; PG8_MMA(1, 0, At, B0); PG8_MMA(1, 1, At, B1); PG8_BAR; PG8_SCHED;
            PG8_LDB(B0, 1, 0); PG8_LDB(B1, 1, 1); PG8_SCHED; PG8_LDA(At, 1, 0); PG8_STAGE(PG8_SA(0, 1), rsA, a2 + hstepA, voffA);
            PG8_WAIT_V(8); PG8_WAIT_L(0); PG8_BAR; PG8_MMA(0, 0, At, B0); PG8_MMA(0, 1, At, B1); PG8_BAR; PG8_SCHED;
            PG8_LDA(At, 1, 1); PG8_STAGE(PG8_SB(1, 0), rsB, b3, voffB); PG8_STAGE(PG8_SB(1, 1), rsB, b3 + hstepB, voffB); PG8_STAGE(PG8_SA(1, 0), rsA, a3, voffA);
            PG8_WAIT_V(8); PG8_WAIT_L(0); PG8_BAR; PG8_MMA(1, 0, At, B0); PG8_MMA(1, 1, At, B1); PG8_BAR; PG8_SCHED;
        }
        if (wr == 0) PG8_BAR;
        E(acc, cur, wr, wc, fr, fq);
        if (!has_next) break;
#pragma unroll
        for (int a = 0; a < 2; ++a)
#pragma unroll
            for (int b = 0; b < 2; ++b)
#pragma unroll
                for (int m = 0; m < 4; ++m)
#pragma unroll
                    for (int n = 0; n < 2; ++n) acc[a][b][m][n] = (f32x4){0.f, 0.f, 0.f, 0.f};
        cur = nxt; cA = nA; cB = nB; ++ui;
        if (wr == 1) PG8_BAR;
    }
    PG8_WAIT_V(0);
    PG8_BAR;
#undef PG8_SA
#undef PG8_SB
#undef PG8_STAGE
#undef PG8_LDA
#undef PG8_LDB
#undef PG8_MMA
#undef PG8_WAIT_V
#undef PG8_WAIT_L
#undef PG8_BAR
#undef PG8_SCHED
#undef PG8_APTR
}
}

using pg8::wt_rsrc; using pg8::st16_wt; using pg8::st8_wt; using pg8::st4_wt; using pg8::bf16_t; using pg8::f32x4; using pg8::f32x2; using pg8::u32x4; using pg8::u32x2; using pg8::cvt_pk_bf16; using pg8::bf_lo; using pg8::bf_hi;
constexpr int NWAVES = 8, NTHR = 512;
constexpr int NB = 4, SEQ = 8192, D = 1024, FF = 4096, T = NB * SEQ, DEPTH = 4;
constexpr float EPS = 1e-6f;
constexpr int LC = 64, NCHUNK = T / LC;
constexpr size_t MiB = 1u << 20;
constexpr size_t WS_CTL = 0, CTL_ZERO_BYTES = 64 * 1024;
constexpr size_t WS_MOD = 1 * MiB;
constexpr size_t WS_PAR = WS_MOD + 512 * 1024;
constexpr int P_NMG = 0, P_NFG = 4096, P_BY = 8192, P_BIN = 10240, P_CW = 12288, P_CB = 20480, P_BA = 22528, P_BX = 24576, P_LC = 26624, P_BOUT = 28672, P_PS = 30720, P_FG = 32768, P_END = 33792;
constexpr size_t WS_AGA = 2 * MiB, WS_AGH = 4 * MiB, WS_CAR = 6 * MiB;
constexpr size_t WS_WYI = 8 * MiB;
constexpr size_t WS_WG = 16 * MiB;
constexpr size_t WS_WOUT = 18 * MiB;
constexpr size_t WS_WPOOL = 22 * MiB;
constexpr size_t WS_W1 = 24 * MiB;
constexpr size_t WS_W2 = 56 * MiB;
constexpr size_t WS_H = 88 * MiB;
constexpr size_t WS_U = 152 * MiB;
constexpr size_t WS_GATE = WS_U, WS_XR = WS_U + 64 * MiB, WS_XC = WS_U + 128 * MiB, WS_LOGA = WS_U + 192 * MiB;
constexpr size_t WS_XB = 408 * MiB;
constexpr size_t WS_END = 472 * MiB;
constexpr int LDS_BYTES = 135168;
constexpr int MISC_OFF = 131072;

#define LAS __attribute__((address_space(3)))
#define LDS_WAIT() asm volatile("s_waitcnt lgkmcnt(0)" ::: "memory")

#define XB_TMO      128
#define XB_XCNT(j)  (256  + 64 * (j))
#define XB_XSUB(j)  (1280 + 64 * (j))
#define XB_XGEN(j)  (2304 + 64 * (j))
#define XB_TOP      3328
#define XB_TOPGEN   3392
#define XCD_BAR_WORDS 3456
#define XB_SPIN_CAP (1u << 18)
__device__ __forceinline__ unsigned xb_ld(unsigned* p)              { return __hip_atomic_load(p, __ATOMIC_RELAXED, __HIP_MEMORY_SCOPE_AGENT); }
__device__ __forceinline__ unsigned xb_add(unsigned* p, unsigned v) { return __hip_atomic_fetch_add(p, v, __ATOMIC_RELAXED, __HIP_MEMORY_SCOPE_AGENT); }
__device__ __forceinline__ unsigned xb_xcc_id() { return (unsigned)__builtin_amdgcn_s_getreg((3 << 11) | 20) & 0xFu; }
#define XB_SPIN(cond, bar) do { unsigned _sp = 0; while (cond) { __builtin_amdgcn_s_sleep(1); \
    if ((++_sp & 255u) == 0u) { if (xb_ld(&(bar)[XB_TMO])) break; if (_sp > XB_SPIN_CAP) { atomicAdd(&(bar)[XB_TMO], 1u); break; } } } } while (0)
struct XcdBarrier { unsigned* bar; unsigned x; volatile LAS unsigned* st; };
__device__ __forceinline__ XcdBarrier xcd_barrier_post(unsigned* bar, volatile LAS unsigned* st) {
    XcdBarrier b; b.bar = bar; b.x = xb_xcc_id(); b.st = st;
    if (threadIdx.x == 0) { (void)xb_add(&bar[XB_XCNT(b.x)], 1u); st[2] = b.x; }
    return b;
}
__device__ __forceinline__ void xcd_barrier_complete(unsigned* bar, unsigned x, unsigned& nloc, unsigned& nx) {
    const unsigned G = gridDim.x * gridDim.y * gridDim.z;
    unsigned sum, cnt, mine, sp = 0u;
    for (;;) {
        sum = 0u; cnt = 0u; mine = 0u;
#pragma unroll
        for (unsigned j = 0; j < 16; ++j) { const unsigned c = xb_ld(&bar[XB_XCNT(j)]); sum += c; cnt += (c > 0u) ? 1u : 0u; mine = (j == x) ? c : mine; }
        if (sum == G) break;
        __builtin_amdgcn_s_sleep(1);
        if ((++sp & 255u) == 0u) { if (xb_ld(&bar[XB_TMO])) break; if (sp > XB_SPIN_CAP) { atomicAdd(&bar[XB_TMO], 1u); break; } }
    }
    nloc = mine > 0u ? mine : 1u; nx = cnt > 0u ? cnt : 1u;
}
__device__ __forceinline__ void xcd_barrier(unsigned* bar, volatile LAS unsigned* st) {
    asm volatile("s_waitcnt vmcnt(0)" ::: "memory");
    __syncthreads();
    if (threadIdx.x == 0) {
        struct { unsigned x; } b; b.x = (unsigned)__builtin_amdgcn_readfirstlane((int)st[2]);
        __builtin_amdgcn_s_waitcnt(0);
        unsigned nloc = st[0], nx = st[1];
        if (nloc == 0u) { xcd_barrier_complete(bar, b.x, nloc, nx); st[0] = nloc; st[1] = nx; }
        const unsigned old = xb_add(&bar[XB_XSUB(b.x)], 1u);
        const unsigned gen = old / nloc;
        if (old + 1u == (gen + 1u) * nloc) {
            __builtin_amdgcn_fence(__ATOMIC_RELEASE, "agent");
            asm volatile("s_waitcnt vmcnt(0)" ::: "memory");
            const unsigned og = xb_add(&bar[XB_TOP], 1u);
            const unsigned tg = og / nx;
            if (og + 1u == (tg + 1u) * nx) xb_add(&bar[XB_TOPGEN], 1u);
            else XB_SPIN(xb_ld(&bar[XB_TOPGEN]) == tg, bar);
            __builtin_amdgcn_fence(__ATOMIC_ACQUIRE, "agent");
            xb_add(&bar[XB_XGEN(b.x)], 1u);
            asm volatile("s_waitcnt vmcnt(0)" ::: "memory");
        } else {
            XB_SPIN(xb_ld(&bar[XB_XGEN(b.x)]) == gen, bar);
            __builtin_amdgcn_fence(__ATOMIC_ACQUIRE, "agent");
            asm volatile("s_waitcnt vmcnt(0)" ::: "memory");
        }
    }
    __syncthreads();
}

__device__ __forceinline__ f32x4 ld4(const float* p) { return __builtin_nontemporal_load((const f32x4*)p); }
__device__ __forceinline__ f32x4 ld4(const bf16_t* p) { const u32x2 w = __builtin_nontemporal_load((const u32x2*)p);
    return (f32x4){bf_lo(w.x), bf_hi(w.x), bf_lo(w.y), bf_hi(w.y)}; }
__device__ __forceinline__ float wave_sum(float v) {
#pragma unroll
    for (int o = 1; o < 64; o <<= 1) v += __shfl_xor(v, o);
    return v;
}

__device__ __forceinline__ void transpose_item(const float* W, int K, int N, bf16_t* WT, int gmode, LAS float* scr, int item, int lane) {
    const int nblk = N / 64, kb = item / nblk, nb = item % nblk, k0 = 32 * kb, n0 = 64 * nb;
    const int rowbase = gmode < 0 ? n0 : (((gmode >> 1) * 2 + (n0 >> 7)) * 256 + (gmode & 1) * 128 + (n0 & 127));
    const float* src = W + (size_t)(k0 + (lane >> 4)) * N + n0 + 4 * (lane & 15);
    f32x4 v[8];
#pragma unroll
    for (int i = 0; i < 8; ++i) v[i] = *(const f32x4*)(src + (size_t)(4 * i) * N);
#pragma unroll
    for (int i = 0; i < 8; ++i) { LAS float* d = scr + ((lane >> 4) + 4 * i) * 65 + 4 * (lane & 15); d[0] = v[i].x; d[1] = v[i].y; d[2] = v[i].z; d[3] = v[i].w; }
    LDS_WAIT(); asm volatile("" ::: "memory");
    const int c = lane & 3;
#pragma unroll
    for (int j = 0; j < 4; ++j) { const int n = (lane >> 2) + 16 * j; const LAS float* s = scr + (8 * c) * 65 + n;
        u32x4 o; o.x = cvt_pk_bf16(s[0 * 65], s[1 * 65]); o.y = cvt_pk_bf16(s[2 * 65], s[3 * 65]); o.z = cvt_pk_bf16(s[4 * 65], s[5 * 65]); o.w = cvt_pk_bf16(s[6 * 65], s[7 * 65]);
        st16_wt(wt_rsrc(WT), (unsigned)((rowbase + n) * K + k0 + 8 * c) * 2u, o); }
    LDS_WAIT(); asm volatile("" ::: "memory");
}

struct Args {
    const float* in[24]; float* out; unsigned char* ws;
};

__device__ __forceinline__ void params_phase(const Args& a, float* PAR, int gtid, int gstride) {
#define CP_PAR(srci, off, n) for (int k = gtid; k < (n); k += gstride) PAR[(off) + k] = a.in[srci][k];
    CP_PAR(4, P_NMG, 4096) CP_PAR(5, P_NFG, 4096) CP_PAR(7, P_BY, 2048) CP_PAR(9, P_BIN, 2048) CP_PAR(10, P_CW, 8192) CP_PAR(11, P_CB, 2048) CP_PAR(13, P_BA, 2048) CP_PAR(15, P_BX, 2048)
    for (int k = gtid; k < 2048; k += gstride) PAR[P_LC + k] = -8.0f * log1pf(expf(-a.in[16][k]));
    CP_PAR(18, P_BOUT, 2048) CP_PAR(20, P_PS, 2048) CP_PAR(23, P_FG, 1024)
#undef CP_PAR
}
__device__ __forceinline__ void mod_phase(const float* c, const float* w_mod, const float* b_mod, float* MOD, LAS float* lf, int tid, int wave, int lane, int bid, int G) {
    for (int i = tid; i < NB * D; i += NTHR) { const float v = c[i]; lf[i] = v / (1.f + __expf(-v)); }
    __syncthreads();
    LAS float* part = lf + NB * D;
    for (int item = bid; item < 192; item += G) {
        const int layer = item / 48, cgp = item % 48;
        const float* wp = w_mod + (size_t)layer * D * 6144 + (size_t)(wave * 128) * 6144 + cgp * 128 + 2 * lane;
        float a[4][2];
#pragma unroll
        for (int b = 0; b < 4; ++b) { a[b][0] = 0.f; a[b][1] = 0.f; }
        for (int kk = 0; kk < 128; kk += 16) {
            f32x2 w[16];
#pragma unroll
            for (int q = 0; q < 16; ++q) w[q] = *(const f32x2*)(wp + (size_t)(kk + q) * 6144);
#pragma unroll
            for (int q = 0; q < 16; ++q) { const int k = wave * 128 + kk + q;
#pragma unroll
                for (int b = 0; b < 4; ++b) { const float cv = lf[b * D + k]; a[b][0] += cv * w[q].x; a[b][1] += cv * w[q].y; } }
        }
#pragma unroll
        for (int b = 0; b < 4; ++b) { part[(wave * 4 + b) * 128 + 2 * lane] = a[b][0]; part[(wave * 4 + b) * 128 + 2 * lane + 1] = a[b][1]; }
        __syncthreads();
        { const int b = tid >> 7, col = tid & 127; float s = 0.f;
#pragma unroll
          for (int w = 0; w < 8; ++w) s += part[(w * 4 + b) * 128 + col];
          const int gc = cgp * 128 + col; MOD[(size_t)(layer * 4 + b) * 6144 + gc] = s + b_mod[layer * 6144 + gc]; }
        __syncthreads();
    }
}

__device__ __forceinline__ void weights_phase(const Args& a, unsigned char* ws, LAS float* scr, int gw, int NGW, int lane) {
    constexpr int NIT = 16384 + 2 * 1920;
    for (int it = gw; it < NIT; it += NGW) {
        int r = it;
        if (r < 16384) { const int i = r >> 12; r &= 4095;
            if (r < 2048) transpose_item(a.in[21] + (size_t)i * D * FF, D, FF, (bf16_t*)(ws + WS_W1) + (size_t)i * D * FF, -1, scr, r, lane);
            else transpose_item(a.in[22] + (size_t)i * D * FF, FF, D, (bf16_t*)(ws + WS_W2) + (size_t)i * D * FF, -1, scr, r - 2048, lane);
        } else { r -= 16384; const int j = r / 1920; r %= 1920;
            bf16_t* wyi = (bf16_t*)(ws + WS_WYI) + (size_t)j * 2048 * 1024;
            if (r < 512) transpose_item(a.in[6] + (size_t)j * D * D, D, D, wyi, -1, scr, r, lane);
            else if (r < 1024) transpose_item(a.in[8] + (size_t)j * D * D, D, D, wyi + (size_t)1024 * 1024, -1, scr, r - 512, lane);
            else if (r < 1536) transpose_item(a.in[17] + (size_t)j * D * D, D, D, (bf16_t*)(ws + WS_WOUT) + (size_t)j * D * D, -1, scr, r - 1024, lane);
            else if (r < 1792) { r -= 1536; const int gt = r >> 7; r &= 127; const int h = r >> 5; r &= 31;
                transpose_item(a.in[gt ? 14 : 12] + (size_t)(j * 4 + h) * 65536, 256, 256, (bf16_t*)(ws + WS_WG) + (size_t)j * 2048 * 256, 2 * h + gt, scr, r, lane); }
            else { r -= 1792; const int gp = r >> 5; r &= 31;
                transpose_item(a.in[19] + (size_t)(j * 4 + gp) * 65536, 256, 256, (bf16_t*)(ws + WS_WPOOL) + (size_t)j * 1024 * 256 + (size_t)gp * 65536, -1, scr, r, lane); }
        }
    }
}

template <typename XT>
__device__ __forceinline__ void norm_phase(const XT* xs, bf16_t* H, bf16_t* xcopy  , const float* gvec, const float* modp, int gw, int NGW, int lane) {
    constexpr int NR = 4;
    const int rpw = (((T + NGW - 1) / NGW) + NR - 1) / NR * NR;
    const int r0 = gw * rpw, r1 = (r0 + rpw < T) ? r0 + rpw : T;
    int curb = -1; f32x4 Gv[4], Sv[4];
    for (int r = r0; r < r1; r += NR) {
        const int b = r / SEQ;
        if (b != curb) { curb = b;
#pragma unroll
            for (int j = 0; j < 4; ++j) { const int c = 256 * j + 4 * lane; const f32x4 g4 = *(const f32x4*)(gvec + c), sc = *(const f32x4*)(modp + b * 6144 + 1024 + c);
                Gv[j] = g4 * (sc + 1.0f); Sv[j] = *(const f32x4*)(modp + b * 6144 + c); } }
        const XT* x0 = xs + (size_t)r * D + 4 * lane;
        f32x4 v[NR][4]; float ss[NR];
#pragma unroll
        for (int q = 0; q < NR; ++q)
#pragma unroll
            for (int j = 0; j < 4; ++j) v[q][j] = ld4(x0 + (size_t)q * D + 256 * j);
        if (xcopy) {
#pragma unroll
            for (int q = 0; q < NR; ++q) { const __amdgpu_buffer_rsrc_t rc = wt_rsrc(xcopy); const unsigned cb = (unsigned)((r + q) * D + 4 * lane) * 2u;
#pragma unroll
                for (int j = 0; j < 4; ++j) st8_wt(rc, cb + 512u * j, (u32x2){cvt_pk_bf16(v[q][j].x, v[q][j].y), cvt_pk_bf16(v[q][j].z, v[q][j].w)}); } }
#pragma unroll
        for (int q = 0; q < NR; ++q) { float s = 0.f;
#pragma unroll
            for (int j = 0; j < 4; ++j) s += (v[q][j].x * v[q][j].x + v[q][j].y * v[q][j].y) + (v[q][j].z * v[q][j].z + v[q][j].w * v[q][j].w);
            ss[q] = s; }
#pragma unroll
        for (int o = 1; o < 64; o <<= 1) {
#pragma unroll
            for (int q = 0; q < NR; ++q) ss[q] += __shfl_xor(ss[q], o); }
#pragma unroll
        for (int q = 0; q < NR; ++q) { const float ri = rsqrtf(ss[q] * (1.f / D) + EPS); const __amdgpu_buffer_rsrc_t rh = wt_rsrc(H); const unsigned hbo = (unsigned)((r + q) * D + 4 * lane) * 2u;
#pragma unroll
            for (int j = 0; j < 4; ++j) { const f32x4 h0 = v[q][j] * ri * Gv[j] + Sv[j]; st8_wt(rh, hbo + 512u * j, (u32x2){cvt_pk_bf16(h0.x, h0.y), cvt_pk_bf16(h0.z, h0.w)}); } }
    }
}
__device__ __forceinline__ void final_norm_phase(const bf16_t* xs, float* out, const float* gvec, int gw, int NGW, int lane) {
    constexpr int NR = 4;
    f32x4 Gv[4];
#pragma unroll
    for (int j = 0; j < 4; ++j) Gv[j] = *(const f32x4*)(gvec + 256 * j + 4 * lane);
    for (int r = gw * NR; r < T; r += NGW * NR) {
        const bf16_t* x0 = xs + (size_t)r * D + 4 * lane;
        f32x4 v[NR][4]; float ss[NR];
#pragma unroll
        for (int q = 0; q < NR; ++q)
#pragma unroll
            for (int j = 0; j < 4; ++j) v[q][j] = ld4(x0 + (size_t)q * D + 256 * j);
#pragma unroll
        for (int q = 0; q < NR; ++q) { float s = 0.f;
#pragma unroll
            for (int j = 0; j < 4; ++j) s += (v[q][j].x * v[q][j].x + v[q][j].y * v[q][j].y) + (v[q][j].z * v[q][j].z + v[q][j].w * v[q][j].w);
            ss[q] = s; }
#pragma unroll
        for (int o = 1; o < 64; o <<= 1) {
#pragma unroll
            for (int q = 0; q < NR; ++q) ss[q] += __shfl_xor(ss[q], o); }
#pragma unroll
        for (int q = 0; q < NR; ++q) { const float ri = rsqrtf(ss[q] * (1.f / D) + EPS); f32x4* o0 = (f32x4*)(out + (size_t)(r + q) * D) + lane;
#pragma unroll
            for (int j = 0; j < 4; ++j) { const f32x4 y = v[q][j] * ri * Gv[j]; st16_wt(wt_rsrc(out), (unsigned)((r + q) * D + 256 * j + 4 * lane) * 4u, __builtin_bit_cast(u32x4, y)); } }
    }
}

__device__ __forceinline__ void pool_phase(const bf16_t* xs, bf16_t* H, const float* gvec, const float* modp, LAS unsigned* hb, int tid, int wave, int lane, int bid, int G) {
    constexpr int CH = 32, HALO = 15, ROWS = CH + HALO;
    for (int chunk = bid; chunk < T / CH; chunk += G) {
        const int t0 = chunk * CH, b = t0 / SEQ, tl0 = t0 - b * SEQ;
        f32x4 Gv[4], Sv[4];
#pragma unroll
        for (int j = 0; j < 4; ++j) { const int c = 256 * j + 4 * lane; const f32x4 g4 = *(const f32x4*)(gvec + c), sc = *(const f32x4*)(modp + b * 6144 + 1024 + c);
            Gv[j] = g4 * (sc + 1.0f); Sv[j] = *(const f32x4*)(modp + b * 6144 + c); }
        for (int rr0 = wave; rr0 < ROWS; rr0 += 6 * NWAVES) {
            f32x4 v0[6][4]; float s3[6];
#pragma unroll
            for (int q = 0; q < 6; ++q) { const int rr = rr0 + q * NWAVES; const bool ok = rr < ROWS && (tl0 - HALO + rr) >= 0;
                const bf16_t* x0 = xs + (size_t)(ok ? t0 - HALO + rr : t0) * D + 4 * lane;
#pragma unroll
                for (int j = 0; j < 4; ++j) v0[q][j] = ld4(x0 + 256 * j); }
#pragma unroll
            for (int q = 0; q < 6; ++q) { float s = 0.f;
#pragma unroll
                for (int j = 0; j < 4; ++j) s += (v0[q][j].x * v0[q][j].x + v0[q][j].y * v0[q][j].y) + (v0[q][j].z * v0[q][j].z + v0[q][j].w * v0[q][j].w);
                s3[q] = s; }
#pragma unroll
            for (int o = 1; o < 64; o <<= 1) {
#pragma unroll
                for (int q = 0; q < 6; ++q) s3[q] += __shfl_xor(s3[q], o); }
#pragma unroll
            for (int q = 0; q < 6; ++q) { const int rr = rr0 + q * NWAVES;
                if (rr < ROWS) { LAS u32x2* dst = (LAS u32x2*)(hb + rr * 512) + lane; const bool ok = (tl0 - HALO + rr) >= 0; const float ri0 = rsqrtf(s3[q] * (1.f / D) + EPS);
#pragma unroll
                    for (int j = 0; j < 4; ++j) { const f32x4 h0 = v0[q][j] * ri0 * Gv[j] + Sv[j]; dst[64 * j] = ok ? (u32x2){cvt_pk_bf16(h0.x, h0.y), cvt_pk_bf16(h0.z, h0.w)} : (u32x2){0u, 0u}; } } }
        }
        __syncthreads();
        {
            const int win = 2 << (tid >> 7);
            float s0 = 0.f, s1 = 0.f;
            for (int k = 1; k < win; ++k) { const unsigned w = hb[(HALO - k) * 512 + tid]; s0 += bf_lo(w); s1 += bf_hi(w); }
            const __amdgpu_buffer_rsrc_t rp = wt_rsrc(H); const unsigned pb = (unsigned)(t0 * D + 2 * tid) * 2u;
#pragma unroll 4
            for (int t = 0; t < CH; ++t) {
                const unsigned w = hb[(HALO + t) * 512 + tid]; const float h0 = bf_lo(w), h1 = bf_hi(w);
                s0 += h0; s1 += h1;
                const int cnt = (tl0 + t + 1 < win) ? (tl0 + t + 1) : win; const float ic = 1.0f / (float)cnt;
                st4_wt(rp, pb + (unsigned)t * 2048u, cvt_pk_bf16(s0 * ic - h0, s1 * ic - h1));
                const unsigned wo = hb[(HALO + t - win + 1) * 512 + tid]; s0 -= bf_lo(wo); s1 -= bf_hi(wo);
            }
        }
        __syncthreads();
    }
}

__device__ __forceinline__ void conv_phase(const bf16_t* XR, bf16_t* XC, const float* cw, const float* cb, int tid, int bid, int G) {
    constexpr int RG = 16;
    const int total = (T / RG) * 128;
    for (int it = bid * NTHR + tid; it < total; it += G * NTHR) {
        const int cg_ = it & 127, rg = it >> 7, t0 = rg * RG, tl0 = t0 & (SEQ - 1), c0 = cg_ * 8;
        f32x4 w[4][2], bb[2];
#pragma unroll
        for (int k = 0; k < 4; ++k) { w[k][0] = *(const f32x4*)(cw + k * D + c0); w[k][1] = *(const f32x4*)(cw + k * D + c0 + 4); }
        bb[0] = *(const f32x4*)(cb + c0); bb[1] = *(const f32x4*)(cb + c0 + 4);
        u32x4 rows[RG + 3];
#pragma unroll
        for (int q = 0; q < RG + 3; ++q) { if (q < 3 && tl0 == 0) rows[q] = (u32x4){0u, 0u, 0u, 0u}; else rows[q] = __builtin_nontemporal_load((const u32x4*)(XR + (size_t)(t0 - 3 + q) * D + c0)); }
#pragma unroll
        for (int t = 0; t < RG; ++t) {
            f32x4 o0 = bb[0], o1 = bb[1];
#pragma unroll
            for (int k = 0; k < 4; ++k) { const u32x4 v = rows[t + k];
                o0 += w[k][0] * (f32x4){bf_lo(v.x), bf_hi(v.x), bf_lo(v.y), bf_hi(v.y)}; o1 += w[k][1] * (f32x4){bf_lo(v.z), bf_hi(v.z), bf_lo(v.w), bf_hi(v.w)}; }
            st16_wt(wt_rsrc(XC), (unsigned)((t0 + t) * D + c0) * 2u, (u32x4){cvt_pk_bf16(o0.x, o0.y), cvt_pk_bf16(o0.z, o0.w), cvt_pk_bf16(o1.x, o1.y), cvt_pk_bf16(o1.z, o1.w)});
        }
    }
}

__device__ __forceinline__ void scan1_phase(const bf16_t* LOGA, const bf16_t* UU, float* AGA, float* AGH, int tid, int bid, int G) {
    for (int ch = bid; ch < NCHUNK; ch += G) {
        const unsigned* la = (const unsigned*)(LOGA + (size_t)ch * LC * D) + tid; const unsigned* up = (const unsigned*)(UU + (size_t)ch * LC * D) + tid;
        float A0 = 0.f, A1 = 0.f, h0 = 0.f, h1 = 0.f;
        for (int t = 0; t < LC; t += 16) {
            unsigned l[16], u[16];
#pragma unroll
            for (int q = 0; q < 16; ++q) { l[q] = __builtin_nontemporal_load(la + (size_t)(t + q) * 512); u[q] = __builtin_nontemporal_load(up + (size_t)(t + q) * 512); }
#pragma unroll
            for (int q = 0; q < 16; ++q) { const float l0 = bf_lo(l[q]), l1 = bf_hi(l[q]); A0 += l0; A1 += l1;
                h0 = __expf(l0) * h0 + bf_lo(u[q]); h1 = __expf(l1) * h1 + bf_hi(u[q]); }
        }
        st8_wt(wt_rsrc(AGA), (unsigned)(ch * D + 2 * tid) * 4u, (u32x2){__float_as_uint(A0), __float_as_uint(A1)}); st8_wt(wt_rsrc(AGH), (unsigned)(ch * D + 2 * tid) * 4u, (u32x2){__float_as_uint(h0), __float_as_uint(h1)});
    }
}
__device__ __forceinline__ void scan2_phase(const float* AGA, const float* AGH, float* CAR, int wave, int lane, int bid) {
    if (wave != 0 || bid >= 64) return;
    const int b = bid >> 4, c = (bid & 15) * 64 + lane;
    const size_t base = (size_t)b * (SEQ / LC) * D + c;
    float carry = 0.f;
    for (int k = 0; k < SEQ / LC; k += 32) {
        float av[32], hv[32];
#pragma unroll
        for (int q = 0; q < 32; ++q) { av[q] = AGA[base + (size_t)(k + q) * D]; hv[q] = AGH[base + (size_t)(k + q) * D]; }
#pragma unroll
        for (int q = 0; q < 32; ++q) { st4_wt(wt_rsrc(CAR), (unsigned)(base + (size_t)(k + q) * D) * 4u, __float_as_uint(carry)); carry = __expf(av[q]) * carry + hv[q]; }
    }
}
__device__ __forceinline__ void scan3_phase(const bf16_t* LOGA, const bf16_t* UU, const bf16_t* GATE, const float* CAR, bf16_t* HG, int tid, int bid, int G) {
    for (int ch = bid; ch < NCHUNK; ch += G) {
        const size_t ro = (size_t)ch * LC * D;
        const unsigned* la = (const unsigned*)(LOGA + ro) + tid; const unsigned* up = (const unsigned*)(UU + ro) + tid; const unsigned* gp = (const unsigned*)(GATE + ro) + tid;
        const __amdgpu_buffer_rsrc_t rg3 = wt_rsrc(HG); const unsigned ob = (unsigned)(ro + 2 * tid) * 2u;
        const f32x2 cv = *(const f32x2*)(CAR + (size_t)ch * D + 2 * tid);
        float h0 = cv.x, h1 = cv.y;
        for (int t = 0; t < LC; t += 16) {
            unsigned l[16], u[16], g[16];
#pragma unroll
            for (int q = 0; q < 16; ++q) { l[q] = __builtin_nontemporal_load(la + (size_t)(t + q) * 512); u[q] = __builtin_nontemporal_load(up + (size_t)(t + q) * 512); g[q] = __builtin_nontemporal_load(gp + (size_t)(t + q) * 512); }
#pragma unroll
            for (int q = 0; q < 16; ++q) { h0 = __expf(bf_lo(l[q])) * h0 + bf_lo(u[q]); h1 = __expf(bf_hi(l[q])) * h1 + bf_hi(u[q]);
                st4_wt(rg3, ob + (unsigned)(t + q) * 2048u, cvt_pk_bf16(h0 * bf_lo(g[q]), h1 * bf_hi(g[q]))); }
        }
    }
}

__global__ void __launch_bounds__(NTHR, 2) fwd_megakernel(Args args) {
    extern __shared__ __attribute__((aligned(16))) unsigned char lds[];
    LAS unsigned char* L = (LAS unsigned char*)lds;
    volatile LAS unsigned* MISC = (volatile LAS unsigned*)(L + MISC_OFF);
    int G = gridDim.x, bid = blockIdx.x, NGW = G * NWAVES;
    int tid = threadIdx.x, lane = tid & 63, wave = __builtin_amdgcn_readfirstlane(tid >> 6), gw = bid * NWAVES + wave;
#define FRESH_TID() do { G = gridDim.x; bid = blockIdx.x; asm volatile("" : "+s"(G), "+s"(bid)); NGW = G * NWAVES; tid = threadIdx.x; asm volatile("" : "+v"(tid)); lane = tid & 63; wave = __builtin_amdgcn_readfirstlane(tid >> 6); gw = bid * NWAVES + wave; } while (0)
    unsigned char* ws = args.ws;
    if (tid < 64) MISC[tid] = 0u;
    __syncthreads();
    (void)xcd_barrier_post((unsigned*)(ws + WS_CTL), MISC + 8);
#define GRID_BAR() do { ws = args.ws; asm volatile("" : "+s"(ws)); xcd_barrier((unsigned*)(ws + WS_CTL), MISC + 8); } while (0)

#define MOD ((float*)(ws + WS_MOD))
#define PAR ((float*)(ws + WS_PAR))
#define Hb ((bf16_t*)(ws + WS_H))
#define Ub ((bf16_t*)(ws + WS_U))
#define GATE ((bf16_t*)(ws + WS_GATE))
#define XR ((bf16_t*)(ws + WS_XR))
#define XC ((bf16_t*)(ws + WS_XC))
#define LOGA ((bf16_t*)(ws + WS_LOGA))
#define UU Hb
#define HG XR
#define Xb ((bf16_t*)(ws + WS_XB))
#define AGA ((float*)(ws + WS_AGA))
#define AGH ((float*)(ws + WS_AGH))
#define CAR ((float*)(ws + WS_CAR))
#define modL (MOD + (size_t)i * 4 * 6144)
    float* X = args.out;
#define FRESH() do { ws = args.ws; X = args.out; asm volatile("" : "+s"(ws), "+s"(X)); FRESH_TID(); } while (0)

    params_phase(args, PAR, bid * NTHR + tid, G * NTHR);
    FRESH(); mod_phase(args.in[1], args.in[2], args.in[3], MOD, (LAS float*)L, tid, wave, lane, bid, G);
    __syncthreads();
    FRESH(); weights_phase(args, ws, (LAS float*)(L + wave * 16384), gw, NGW, lane);
    if (args.ws == nullptr) cg::this_grid().sync();
    GRID_BAR();

    for (int i = 0; i < DEPTH; ++i) {
        const int j = i >> 1;
        if ((i & 1) == 0) {
            FRESH(); if (i == 0) norm_phase<float>(args.in[0], Hb, Xb, PAR + P_NMG + i * D, modL, gw, NGW, lane);
            else norm_phase<bf16_t>(Xb, Hb, nullptr, PAR + P_NMG + i * D, modL, gw, NGW, lane);
            GRID_BAR();
            FRESH(); { pg8::Gemm g{Hb, (const bf16_t*)(ws + WS_WYI) + (size_t)j * 2048 * 1024, T, 2048, D, D, -1}; pg8::StaticOrder S; S.init(T, 2048, G, bid);
              pg8::EpiG1 E{GATE, XR, PAR + P_BY + j * D, PAR + P_BIN + j * D};
              pg8::gemm_phase<pg8::EpiG1, pg8::StaticOrder>(L, g, S, E); }
            GRID_BAR();
            FRESH(); conv_phase(XR, XC, PAR + P_CW + j * 4 * D, PAR + P_CB + j * D, tid, bid, G);
            GRID_BAR();
            FRESH(); { pg8::Gemm g{XC, (const bf16_t*)(ws + WS_WG) + (size_t)j * 2048 * 256, T, 2048, 256, D, 1}; pg8::StaticOrder S; S.init(T, 2048, G, bid);
              pg8::EpiGates E{XC, LOGA, UU, PAR + P_BA + j * D, PAR + P_BX + j * D, PAR + P_LC + j * D};
              pg8::gemm_phase<pg8::EpiGates, pg8::StaticOrder>(L, g, S, E); }
            GRID_BAR();
            FRESH(); scan1_phase(LOGA, UU, AGA, AGH, tid, bid, G);
            GRID_BAR();
            FRESH(); scan2_phase(AGA, AGH, CAR, wave, lane, bid);
            GRID_BAR();
            FRESH(); scan3_phase(LOGA, UU, GATE, CAR, HG, tid, bid, G);
            GRID_BAR();
            FRESH(); { pg8::Gemm g{HG, (const bf16_t*)(ws + WS_WOUT) + (size_t)j * D * D, T, D, D, D, -1}; pg8::StaticOrder S; S.init(T, D, G, bid);
              pg8::EpiXUpd E{Xb, Xb, modL + 2048, PAR + P_BOUT + j * D, nullptr};
              pg8::gemm_phase<pg8::EpiXUpd, pg8::StaticOrder>(L, g, S, E); }
            GRID_BAR();
        } else {
            FRESH(); pool_phase(Xb, Hb, PAR + P_NMG + i * D, modL, (LAS unsigned*)L, tid, wave, lane, bid, G);
            GRID_BAR();
            FRESH(); { pg8::Gemm g{Hb, (const bf16_t*)(ws + WS_WPOOL) + (size_t)j * 1024 * 256, T, D, 256, D, 0}; pg8::StaticOrder S; S.init(T, D, G, bid);
              pg8::EpiXUpd E{Xb, Xb, modL + 2048, nullptr, PAR + P_PS + j * D};
              pg8::gemm_phase<pg8::EpiXUpd, pg8::StaticOrder>(L, g, S, E); }
            GRID_BAR();
        }
        FRESH(); norm_phase<bf16_t>(Xb, Hb, nullptr, PAR + P_NFG + i * D, modL + 3072, gw, NGW, lane);
        GRID_BAR();
        FRESH(); { pg8::Gemm g{Hb, (const bf16_t*)(ws + WS_W1) + (size_t)i * D * FF, T, FF, D, D, -1}; pg8::StaticOrder S; S.init(T, FF, G, bid);
          pg8::EpiFF1 E{Ub};
          pg8::gemm_phase<pg8::EpiFF1, pg8::StaticOrder>(L, g, S, E); }
        GRID_BAR();
        FRESH(); { pg8::Gemm g{Ub, (const bf16_t*)(ws + WS_W2) + (size_t)i * D * FF, T, D, FF, FF, -1}; pg8::StaticOrder S; S.init(T, D, G, bid, 8);
          pg8::EpiXUpd E{Xb, Xb, modL + 5120, nullptr, nullptr};
          pg8::gemm_phase<pg8::EpiXUpd, pg8::StaticOrder>(L, g, S, E); }
        GRID_BAR();
    }
    FRESH(); final_norm_phase(Xb, X, PAR + P_FG, gw, NGW, lane);
}

extern "C" void kernel_launch(void* const* d_in, const int* in_sizes, int n_in, void* d_out, int out_size, void* d_ws, size_t ws_size, hipStream_t stream) {
    static int grid = 0;
    if (grid == 0) {
        if (n_in != 24 || in_sizes[0] != T * D || out_size != T * D || ws_size < WS_END) { fprintf(stderr, "kernel_launch: unexpected shapes (n_in %d, in0 %d, out %d, ws %zu); nothing launched\n", n_in, n_in > 0 ? in_sizes[0] : -1, out_size, ws_size); grid = -1; return; }
        int dev = 0, cus = 0, per_cu = 0;
        if (hipGetDevice(&dev) != hipSuccess || hipDeviceGetAttribute(&cus, hipDeviceAttributeMultiprocessorCount, dev) != hipSuccess) { grid = -1; return; }
        if (hipFuncSetAttribute((const void*)fwd_megakernel, hipFuncAttributeMaxDynamicSharedMemorySize, LDS_BYTES) != hipSuccess) { fprintf(stderr, "kernel_launch: hipFuncSetAttribute failed\n"); grid = -1; return; }
        if (hipOccupancyMaxActiveBlocksPerMultiprocessor(&per_cu, (const void*)fwd_megakernel, NTHR, LDS_BYTES) != hipSuccess || per_cu < 1) { fprintf(stderr, "kernel_launch: occupancy query says %d blocks per CU\n", per_cu); per_cu = 1; }
        (void)hipGetLastError();
        grid = cus;
    }
    if (grid < 0) return;
    (void)hipMemsetAsync((char*)d_ws + WS_CTL, 0, CTL_ZERO_BYTES, stream);
    Args a{};
    for (int i = 0; i < 24; ++i) a.in[i] = (const float*)d_in[i];
    a.out = (float*)d_out; a.ws = (unsigned char*)d_ws;
    void* kargs[] = {&a};
    hipError_t e = hipLaunchCooperativeKernel((const void*)fwd_megakernel, dim3(grid), dim3(NTHR), kargs, LDS_BYTES, stream);
    if (e != hipSuccess) fprintf(stderr, "kernel_launch: cooperative launch failed: %s (grid %d)\n", hipGetErrorString(e), grid);
}
```
